# Optimizing an MI355X kernel written in HIP

```python
import math
import jax, jax.numpy as jnp
from jax import lax
import numpy as np

D_MODEL = 1024
BATCH = 2
SEQ = 8192
DEPTH = 1

N_Q_HEADS = 16
N_KV_HEADS = 4
HEAD_DIM = 64
WINDOW = 128
ATTN_BLOCK = 128
ATTN_Q = N_Q_HEADS * HEAD_DIM
ATTN_KV = N_KV_HEADS * HEAD_DIM
SSM_EXPAND = 2
D_INNER = SSM_EXPAND * D_MODEL
SSM_HEAD_DIM = 64
N_SSM_HEADS = D_INNER // SSM_HEAD_DIM
N_SSM_GROUPS = 4
HEADS_PER_GROUP = N_SSM_HEADS // N_SSM_GROUPS
D_STATE = 128
CONV_WIDTH = 4
CHUNK = 128
CONV_DIM = D_INNER + 2 * N_SSM_GROUPS * D_STATE
OFF_Q = 0
OFF_K = OFF_Q + ATTN_Q
OFF_V = OFF_K + ATTN_KV
OFF_Z = OFF_V + ATTN_KV
OFF_XBC = OFF_Z + D_INNER
OFF_DT = OFF_XBC + CONV_DIM
OFF_GA = OFF_DT + N_SSM_HEADS
OFF_GS = OFF_GA + D_MODEL
D_IN_PROJ = OFF_GS + D_MODEL
D_FF = 2816
FFN_RES_WEIGHT = 0.5
LN_EPS = 1e-5
RMS_EPS = 1e-5
DEEPNORM_ALPHA = (2.0 * DEPTH) ** 0.25
DEEPNORM_BETA = (8.0 * DEPTH) ** -0.25

kernel_name = "hybrid_swa_sink_ssd_macaron_deepnorm"


def layer_norm(x, g, b):
    xf = x.astype(jnp.float32)
    mu = jnp.mean(xf, axis=-1, keepdims=True)
    var = jnp.mean(jnp.square(xf - mu), axis=-1, keepdims=True)
    y = (xf - mu) * lax.rsqrt(var + LN_EPS)
    return (y * g.astype(jnp.float32) + b.astype(jnp.float32)).astype(x.dtype)


def swiglu(x, w_gate, w_up, w_down):
    return (jax.nn.silu(x @ w_gate) * (x @ w_up)) @ w_down


def causal_depthwise_conv(u, w, b):
    y = lax.conv_general_dilated(u, w[:, None, :], window_strides=(1,), padding=[(CONV_WIDTH - 1, 0)],
                                 dimension_numbers=("NWC", "WIO", "NWC"), feature_group_count=u.shape[-1])
    return y + b


def sliding_window_sink_attention(q, k, v, sinks):
    b, s = q.shape[0], q.shape[1]
    nb = s // ATTN_BLOCK
    rep = N_Q_HEADS // N_KV_HEADS
    qb = q.reshape(b, nb, ATTN_BLOCK, N_KV_HEADS, rep, HEAD_DIM)
    kb = k.reshape(b, nb, ATTN_BLOCK, N_KV_HEADS, HEAD_DIM)
    vb = v.reshape(b, nb, ATTN_BLOCK, N_KV_HEADS, HEAD_DIM)

    def with_prev(t):
        prev = jnp.pad(t, ((0, 0), (1, 0), (0, 0), (0, 0), (0, 0)))[:, :-1]
        return jnp.concatenate([prev, t], axis=2)

    kk, vv = with_prev(kb), with_prev(vb)
    scores = jnp.einsum("bnqgrd,bnkgd->bngrqk", qb, kk).astype(jnp.float32) * (HEAD_DIM ** -0.5)
    qi = jnp.arange(ATTN_BLOCK)[:, None] + ATTN_BLOCK
    kj = jnp.arange(2 * ATTN_BLOCK)[None, :]
    diff = qi - kj
    band = (diff >= 0) & (diff < WINDOW)
    in_cur = jnp.arange(2 * ATTN_BLOCK) >= ATTN_BLOCK
    mask = band[None] & ((jnp.arange(nb)[:, None, None] > 0) | in_cur[None, None, :])
    scores = jnp.where(mask[None, :, None, None], scores, -jnp.inf)
    sink = sinks.astype(jnp.float32).reshape(N_KV_HEADS, rep)[None, None, :, :, None, None]
    sink = jnp.broadcast_to(sink, scores.shape[:-1] + (1,))
    probs = jax.nn.softmax(jnp.concatenate([scores, sink], axis=-1), axis=-1)[..., :-1]
    out = jnp.einsum("bngrqk,bnkgd->bnqgrd", probs.astype(v.dtype), vv)
    return out.reshape(b, s, ATTN_Q)


def segsum_exp(a):
    t = a.shape[-1]
    rep = jnp.broadcast_to(a[..., None], a.shape + (t,))
    strict = jnp.tril(jnp.ones((t, t), dtype=bool), -1)
    cs = jnp.cumsum(jnp.where(strict, rep, 0.0), axis=-2)
    incl = jnp.tril(jnp.ones((t, t), dtype=bool), 0)
    return jnp.exp(jnp.where(incl, cs, -jnp.inf))


def ssd_chunked(x, dt, A, B, C):
    b, L = x.shape[0], x.shape[1]
    nc = L // CHUNK
    G, K, P, N = N_SSM_GROUPS, HEADS_PER_GROUP, SSM_HEAD_DIM, D_STATE
    xdt = (x * dt[..., None]).reshape(b, nc, CHUNK, G, K, P)
    dA = (dt * A).reshape(b, nc, CHUNK, G, K).transpose(0, 1, 3, 4, 2)
    Bc = B.reshape(b, nc, CHUNK, G, N)
    Cc = C.reshape(b, nc, CHUNK, G, N)
    A_cum = jnp.cumsum(dA, axis=-1)
    Lmat = segsum_exp(dA)
    CB = jnp.einsum("bclgn,bcsgn->bcgls", Cc, Bc)
    y_diag = jnp.einsum("bcgls,bcgkls,bcsgkp->bclgkp", CB, Lmat, xdt)
    decay_states = jnp.exp(A_cum[..., -1:] - A_cum)
    states = jnp.einsum("bclgn,bcgkl,bclgkp->bcgkpn", Bc, decay_states, xdt)
    chunk_decay = jnp.exp(A_cum[..., -1])

    def step(h, inp):
        s_c, d_c = inp
        return d_c[..., None, None] * h + s_c, h

    h0 = jnp.zeros((b, G, K, P, N), dtype=x.dtype)
    _, prev = lax.scan(step, h0, (jnp.moveaxis(states, 1, 0), jnp.moveaxis(chunk_decay, 1, 0)))
    prev = jnp.moveaxis(prev, 0, 1)
    y_off = jnp.einsum("bclgn,bcgkpn,bcgkl->bclgkp", Cc, prev, jnp.exp(A_cum))
    return (y_diag + y_off).reshape(b, L, G, K, P)


def ssd_branch(z, xbc, dt_raw, conv_w, conv_b, dt_bias, a_log, d_skip, norm_w):
    b, L = z.shape[0], z.shape[1]
    xbc = jax.nn.silu(causal_depthwise_conv(xbc, conv_w, conv_b))
    xs = xbc[..., :D_INNER]
    Bs = xbc[..., D_INNER:D_INNER + N_SSM_GROUPS * D_STATE].reshape(b, L, N_SSM_GROUPS, D_STATE)
    Cs = xbc[..., D_INNER + N_SSM_GROUPS * D_STATE:].reshape(b, L, N_SSM_GROUPS, D_STATE)
    xh = xs.astype(jnp.float32).reshape(b, L, N_SSM_GROUPS, HEADS_PER_GROUP, SSM_HEAD_DIM)
    dt = jax.nn.softplus(dt_raw.astype(jnp.float32) + dt_bias.astype(jnp.float32))
    dt = dt.reshape(b, L, N_SSM_GROUPS, HEADS_PER_GROUP)
    A = -jnp.exp(a_log.astype(jnp.float32)).reshape(N_SSM_GROUPS, HEADS_PER_GROUP)
    y = ssd_chunked(xh, dt, A, Bs.astype(jnp.float32), Cs.astype(jnp.float32))
    y = y + d_skip.astype(jnp.float32).reshape(N_SSM_GROUPS, HEADS_PER_GROUP)[..., None] * xh
    u = (y.reshape(b, L, D_INNER) * jax.nn.silu(z.astype(jnp.float32))).reshape(b, L, N_SSM_GROUPS, -1)
    u = u * lax.rsqrt(jnp.mean(jnp.square(u), axis=-1, keepdims=True) + RMS_EPS)
    u = u.reshape(b, L, D_INNER) * norm_w.astype(jnp.float32)
    return u.astype(z.dtype)


def hybrid_mixer(h, w_in, conv_w, conv_b, dt_bias, a_log, d_skip, ssm_norm_w, sinks, w_attn_branch, w_ssm_branch, w_out):
    b, s = h.shape[0], h.shape[1]
    proj = h @ w_in
    q = proj[..., OFF_Q:OFF_K].reshape(b, s, N_Q_HEADS, HEAD_DIM)
    k = proj[..., OFF_K:OFF_V].reshape(b, s, N_KV_HEADS, HEAD_DIM)
    v = proj[..., OFF_V:OFF_Z].reshape(b, s, N_KV_HEADS, HEAD_DIM)
    z = proj[..., OFF_Z:OFF_XBC]
    xbc = proj[..., OFF_XBC:OFF_DT]
    dt_raw = proj[..., OFF_DT:OFF_GA]
    gate_attn = jax.nn.sigmoid(proj[..., OFF_GA:OFF_GS])
    gate_ssm = jax.nn.sigmoid(proj[..., OFF_GS:])
    y_attn = sliding_window_sink_attention(q, k, v, sinks) @ w_attn_branch
    y_ssm = ssd_branch(z, xbc, dt_raw, conv_w, conv_b, dt_bias, a_log, d_skip, ssm_norm_w) @ w_ssm_branch
    merged = gate_attn * y_attn + gate_ssm * y_ssm
    return merged @ w_out


def _normal(k, shape, scale):
    return jax.random.normal(k, shape, jnp.float32) * scale


def setup_inputs(seed: int = 0) -> dict:
    key = jax.random.key(seed)
    ks = jax.random.split(key, 32)
    ffn_in = D_MODEL ** -0.5
    ffn_out = (D_FF ** -0.5) * DEEPNORM_BETA
    u = jax.random.uniform(ks[10], (DEPTH, N_SSM_HEADS), jnp.float32)
    dt0 = jnp.exp(u * (math.log(0.1) - math.log(0.001)) + math.log(0.001))
    dt_bias = dt0 + jnp.log(-jnp.expm1(-dt0))
    return {
        "x": jax.random.normal(ks[0], (BATCH, SEQ, D_MODEL), jnp.float32),
        "ffn1_w_gate": _normal(ks[1], (DEPTH, D_MODEL, D_FF), ffn_in),
        "ffn1_w_up": _normal(ks[2], (DEPTH, D_MODEL, D_FF), ffn_in),
        "ffn1_w_down": _normal(ks[3], (DEPTH, D_FF, D_MODEL), ffn_out),
        "ln1_g": 1.0 + _normal(ks[4], (DEPTH, D_MODEL), 0.02),
        "ln1_b": _normal(ks[5], (DEPTH, D_MODEL), 0.02),
        "w_in": _normal(ks[6], (DEPTH, D_MODEL, D_IN_PROJ), D_MODEL ** -0.5),
        "conv_w": _normal(ks[7], (DEPTH, CONV_WIDTH, CONV_DIM), CONV_WIDTH ** -0.5),
        "conv_b": _normal(ks[8], (DEPTH, CONV_DIM), 0.02),
        "dt_bias": dt_bias,
        "a_log": jnp.log(jax.random.uniform(ks[11], (DEPTH, N_SSM_HEADS), jnp.float32, 1.0, 16.0)),
        "d_skip": 1.0 + _normal(ks[12], (DEPTH, N_SSM_HEADS), 0.02),
        "ssm_norm_w": 1.0 + _normal(ks[13], (DEPTH, D_INNER), 0.02),
        "sinks": _normal(ks[14], (DEPTH, N_Q_HEADS), 0.5),
        "w_attn_branch": _normal(ks[15], (DEPTH, ATTN_Q, D_MODEL), ATTN_Q ** -0.5),
        "w_ssm_branch": _normal(ks[16], (DEPTH, D_INNER, D_MODEL), D_INNER ** -0.5),
        "w_out": _normal(ks[17], (DEPTH, D_MODEL, D_MODEL), (D_MODEL ** -0.5) * DEEPNORM_BETA),
        "ln2_g": 1.0 + _normal(ks[18], (DEPTH, D_MODEL), 0.02),
        "ln2_b": _normal(ks[19], (DEPTH, D_MODEL), 0.02),
        "ffn2_w_gate": _normal(ks[20], (DEPTH, D_MODEL, D_FF), ffn_in),
        "ffn2_w_up": _normal(ks[21], (DEPTH, D_MODEL, D_FF), ffn_in),
        "ffn2_w_down": _normal(ks[22], (DEPTH, D_FF, D_MODEL), ffn_out),
        "ln3_g": 1.0 + _normal(ks[23], (DEPTH, D_MODEL), 0.02),
        "ln3_b": _normal(ks[24], (DEPTH, D_MODEL), 0.02),
    }


def reference(x, ffn1_w_gate, ffn1_w_up, ffn1_w_down, ln1_g, ln1_b, w_in, conv_w, conv_b, dt_bias, a_log, d_skip,
              ssm_norm_w, sinks, w_attn_branch, w_ssm_branch, w_out, ln2_g, ln2_b, ffn2_w_gate, ffn2_w_up,
              ffn2_w_down, ln3_g, ln3_b):
    for i in range(DEPTH):
        x = layer_norm(DEEPNORM_ALPHA * x + FFN_RES_WEIGHT * swiglu(x, ffn1_w_gate[i], ffn1_w_up[i], ffn1_w_down[i]),
                       ln1_g[i], ln1_b[i])
        mix = hybrid_mixer(x, w_in[i], conv_w[i], conv_b[i], dt_bias[i], a_log[i], d_skip[i], ssm_norm_w[i],
                           sinks[i], w_attn_branch[i], w_ssm_branch[i], w_out[i])
        x = layer_norm(DEEPNORM_ALPHA * x + mix, ln2_g[i], ln2_b[i])
        x = layer_norm(DEEPNORM_ALPHA * x + FFN_RES_WEIGHT * swiglu(x, ffn2_w_gate[i], ffn2_w_up[i], ffn2_w_down[i]),
                       ln3_g[i], ln3_b[i])
    return x
```

```cpp
#include <hip/hip_runtime.h>
#include <hip/hip_cooperative_groups.h>
#include <cstdio>
#include <cstdint>
namespace cg = cooperative_groups;
namespace pg8 {
#define PG8_LAS __attribute__((address_space(3)))
typedef unsigned short bf16_t;
typedef short bf16x8 __attribute__((ext_vector_type(8)));
typedef float f32x4 __attribute__((ext_vector_type(4)));
typedef unsigned u32x4 __attribute__((ext_vector_type(4)));
constexpr int BM = 256, BK = 64, HALF = 128, HTB = HALF * BK * 2  , STAGE_BYTES = 8 * HTB, NXCD = 8, WGM = 8;

__host__ __device__ __forceinline__ int lds_byte(int r, int c) { const int st = (r >> 4) * 2 + (c >> 5), rr = r & 15, cc = c & 31, ob = rr * 64 + cc * 2; return st * 1024 + (ob ^ (((ob >> 9) & 1) << 5)); }
__host__ __device__ __forceinline__ void stage_rc(int b, int& R, int& C) { const int st = b / 1024, sb = b % 1024, swz = sb ^ (((sb >> 9) & 1) << 5); R = (st >> 1) * 16 + swz / 64; C = (st & 1) * 32 + (swz % 64) / 2; }
__host__ __device__ __forceinline__ int perm32(int rho) { const int n = rho >> 4, i = rho & 15; return 8 * (i >> 2) + 4 * n + (i & 3); }

struct Unit { int pm, pn; };
struct Gemm { const bf16_t* A; const bf16_t* Bt; int M, N, K, lda; };

struct StaticOrder {
    int nM, nN, nwg, G, c;
    __host__ __device__ void init(int M, int N, int G_, int c_) { nM = M / BM; nN = N / BM; nwg = nM * nN; G = G_; c = c_; }
    __host__ __device__ bool next(int i, Unit& u) const {
        const long L = (long)i * G + c; if (L >= nwg) return false;
        int wgid = (int)L; { const int q = nwg / NXCD, r = nwg % NXCD, xcd = wgid % NXCD, off = wgid / NXCD; wgid = (xcd < r ? xcd * (q + 1) : r * (q + 1) + (xcd - r) * q) + off; }
        const int nig = WGM * nN, gid = wgid / nig, fm = gid * WGM, gsz = (nM - fm) < WGM ? (nM - fm) : WGM;
        u.pm = fm + ((wgid % nig) % gsz); u.pn = (wgid % nig) / gsz; return true;
    }
    __device__ __forceinline__ void a_ready(const Unit&) const {}
    __device__ __forceinline__ void done(const Unit&) const {}
};

typedef float f32x2_t __attribute__((ext_vector_type(2))); typedef __bf16 bf16x2_t __attribute__((ext_vector_type(2)));
__device__ __forceinline__ unsigned cvtpk(float lo, float hi) { f32x2_t v = {lo, hi}; bf16x2_t b = __builtin_convertvector(v, bf16x2_t); return __builtin_bit_cast(unsigned, b); }
__device__ __forceinline__ float bflo(unsigned w) { return __uint_as_float(w << 16); }
__device__ __forceinline__ float bfhi(unsigned w) { return __uint_as_float(w & 0xffff0000u); }
__device__ __forceinline__ float sigmoidf_(float x) { return __builtin_amdgcn_rcpf(1.0f + __builtin_amdgcn_exp2f(-1.4426950408889634f * x)); }
__device__ __forceinline__ float siluf_(float x) { return x * sigmoidf_(x); }

struct EpiSwiGLU {
    static constexpr bool PERM = true, AFTER_DRAIN = false, HAS_MID = false; int mid_t;
    bf16_t* O; int ldc;
    __device__ __forceinline__ void mid(f32x4 (&)[2][2][4][2], const Unit&, int, int, int, int) const {}
    __device__ __forceinline__ void operator()(const f32x4 (&acc)[2][2][4][2], const Unit& u, int wr, int wc, int fr, int fq) const {
        const int row0 = u.pm * BM + wr * 64 + fr, col0 = u.pn * HALF + wc * 32 + 8 * fq;
#pragma unroll
        for (int ai = 0; ai < 2; ++ai)
#pragma unroll
            for (int m = 0; m < 4; ++m) { bf16_t* rowp = O + (size_t)(row0 + ai * HALF + m * 16) * ldc + col0;
                const f32x4 g0 = acc[ai][0][m][0], g1 = acc[ai][0][m][1], u0 = acc[ai][1][m][0], u1 = acc[ai][1][m][1];
                u32x4 w; w.x = cvtpk(siluf_(g0[0]) * u0[0], siluf_(g0[1]) * u0[1]); w.y = cvtpk(siluf_(g0[2]) * u0[2], siluf_(g0[3]) * u0[3]);
                w.z = cvtpk(siluf_(g1[0]) * u1[0], siluf_(g1[1]) * u1[1]); w.w = cvtpk(siluf_(g1[2]) * u1[2], siluf_(g1[3]) * u1[3]);
                *(u32x4*)rowp = w; }
    }
};
struct EpiResid {
    static constexpr bool PERM = false, AFTER_DRAIN = false, HAS_MID = false; int mid_t;
    const float* res; float* out; int ldc; float alpha, s;
    __device__ __forceinline__ void mid(f32x4 (&)[2][2][4][2], const Unit&, int, int, int, int) const {}
    __device__ __forceinline__ void operator()(const f32x4 (&acc)[2][2][4][2], const Unit& u, int wr, int wc, int fr, int fq) const {
        const int row0 = u.pm * BM + wr * 64 + fr, col0 = u.pn * BM + wc * 32 + 4 * fq;
#pragma unroll
        for (int ai = 0; ai < 2; ++ai)
#pragma unroll
            for (int m = 0; m < 4; ++m) { const size_t off = (size_t)(row0 + ai * HALF + m * 16) * ldc + col0;
#pragma unroll
                for (int bj = 0; bj < 2; ++bj)
#pragma unroll
                    for (int n = 0; n < 2; ++n) { const f32x4 r = *(const f32x4*)(res + off + bj * HALF + n * 16); *(f32x4*)(out + off + bj * HALF + n * 16) = r * alpha + acc[ai][bj][m][n] * s; } }
    }
};
struct EpiInProj {
    static constexpr bool PERM = true, AFTER_DRAIN = false, HAS_MID = false; int mid_t;
    bf16_t* O; int ldc; float* dt;
    __device__ __forceinline__ void mid(f32x4 (&)[2][2][4][2], const Unit&, int, int, int, int) const {}
    __device__ __forceinline__ void operator()(const f32x4 (&acc)[2][2][4][2], const Unit& u, int wr, int wc, int fr, int fq) const {
        const int row0 = u.pm * BM + wr * 64 + fr;
        if (u.pn == 34) {
            if (wc == 0) {
#pragma unroll
                for (int ai = 0; ai < 2; ++ai)
#pragma unroll
                    for (int m = 0; m < 4; ++m) { float* p = dt + (size_t)(row0 + ai * HALF + m * 16) * 32 + 8 * fq; *(f32x4*)p = acc[ai][0][m][0]; *(f32x4*)(p + 4) = acc[ai][0][m][1]; }
            }
            return;
        }
        const bool gate = u.pn >= 26; const int col0 = u.pn * BM + wc * 32 + 8 * fq;
#pragma unroll
        for (int ai = 0; ai < 2; ++ai)
#pragma unroll
            for (int m = 0; m < 4; ++m) { bf16_t* rowp = O + (size_t)(row0 + ai * HALF + m * 16) * ldc + col0;
#pragma unroll
                for (int bj = 0; bj < 2; ++bj) { f32x4 v0 = acc[ai][bj][m][0], v1 = acc[ai][bj][m][1];
                    if (gate) {
#pragma unroll
                        for (int i = 0; i < 4; ++i) { v0[i] = sigmoidf_(v0[i]); v1[i] = sigmoidf_(v1[i]); } }
                    u32x4 w; w.x = cvtpk(v0[0], v0[1]); w.y = cvtpk(v0[2], v0[3]); w.z = cvtpk(v1[0], v1[1]); w.w = cvtpk(v1[2], v1[3]);
                    *(u32x4*)(rowp + bj * HALF) = w; } }
    }
};
template <int MODE> struct EpiGate {
    static constexpr bool PERM = true, AFTER_DRAIN = false, HAS_MID = false; int mid_t;
    bf16_t* G; int ldc; int gsoff;
    __device__ __forceinline__ void mid(f32x4 (&)[2][2][4][2], const Unit&, int, int, int, int) const {}
    __device__ __forceinline__ void operator()(const f32x4 (&acc)[2][2][4][2], const Unit& u, int wr, int wc, int fr, int fq) const {
        const int row0 = u.pm * BM + wr * 64 + fr, col0 = u.pn * BM + wc * 32 + 8 * fq;
#pragma unroll
        for (int ai = 0; ai < 2; ++ai)
#pragma unroll
            for (int m = 0; m < 4; ++m) { bf16_t* rowp = G + (size_t)(row0 + ai * HALF + m * 16) * ldc + col0;
#pragma unroll
                for (int bj = 0; bj < 2; ++bj) { const u32x4 t = *(const u32x4*)(rowp + bj * HALF); const f32x4 v0 = acc[ai][bj][m][0], v1 = acc[ai][bj][m][1]; u32x4 w;
                    if (MODE == 0) { w.x = cvtpk(v0[0] * bflo(t.x), v0[1] * bfhi(t.x)); w.y = cvtpk(v0[2] * bflo(t.y), v0[3] * bfhi(t.y));
                        w.z = cvtpk(v1[0] * bflo(t.z), v1[1] * bfhi(t.z)); w.w = cvtpk(v1[2] * bflo(t.w), v1[3] * bfhi(t.w)); }
                    else { const u32x4 s = *(const u32x4*)(rowp + bj * HALF + gsoff);
                        w.x = cvtpk(bflo(t.x) + v0[0] * bflo(s.x), bfhi(t.x) + v0[1] * bfhi(s.x)); w.y = cvtpk(bflo(t.y) + v0[2] * bflo(s.y), bfhi(t.y) + v0[3] * bfhi(s.y));
                        w.z = cvtpk(bflo(t.z) + v1[0] * bflo(s.z), bfhi(t.z) + v1[1] * bfhi(s.z)); w.w = cvtpk(bflo(t.w) + v1[2] * bflo(s.w), bfhi(t.w) + v1[3] * bfhi(s.w)); }
                    *(u32x4*)(rowp + bj * HALF) = w; } }
    }
};
template <class Epi, class Sched, bool ALIGN_EPI = false, bool SP2 = false>
__device__ __forceinline__ void gemm_phase(PG8_LAS unsigned char* lds, const Gemm g, const Sched& S, const Epi& E) {
    int tid_ = threadIdx.x; asm volatile("" : "+v"(tid_)); const int tid = tid_, wid = __builtin_amdgcn_readfirstlane(tid >> 6), lane = tid & 63, wr = wid >> 2, wc = wid & 3, fr = lane & 15, fq = lane >> 4;
    const int K = g.K, nt = K / BK;
    unsigned voffA[2], voffB[2];
#pragma unroll
    for (int i = 0; i < 2; ++i) { int R, C; stage_rc(tid * 16 + i * 8192, R, C); const int Rb = Epi::PERM ? ((R & ~31) + perm32(R & 31)) : R;
        voffA[i] = (unsigned)(R * g.lda + C) * 2u; voffB[i] = (unsigned)(Rb * K + C) * 2u; }
    const size_t kstep = (size_t)(BK * 2);
    const size_t hstepB = (size_t)HALF * K * 2, hstepA = (size_t)HALF * g.lda * 2;
    const size_t tstepA = 2 * hstepA, tstepB = 2 * hstepB;
    const unsigned ldsw = (unsigned)wid * 1024u;
    const int aoff = lds_byte(wr * 64 + fr, fq * 8), boff = lds_byte(wc * 32 + fr, fq * 8);
#define PG8_SA(b, h) (((b) * 2 + (h)) * HTB)
#define PG8_SB(b, h) ((4 + (b) * 2 + (h)) * HTB)
#define PG8_STAGE(bufoff, gbase, voff) do { _Pragma("unroll") for (int _i = 0; _i < 2; ++_i) \
        __builtin_amdgcn_global_load_lds((const unsigned*)((const char*)(gbase) + (voff)[_i]), (PG8_LAS unsigned*)(lds + (bufoff) + ldsw + _i * 8192), 16, 0, 0); } while (0)
#define PG8_LDA(dst, b, h) do { _Pragma("unroll") for (int m = 0; m < 4; ++m) _Pragma("unroll") for (int k = 0; k < 2; ++k) dst[m][k] = *(const PG8_LAS bf16x8*)(lds + PG8_SA(b, h) + aoff + m * 2048 + k * 1024); } while (0)
#define PG8_LDB(dst, b, h) do { _Pragma("unroll") for (int n = 0; n < 2; ++n) _Pragma("unroll") for (int k = 0; k < 2; ++k) dst[n][k] = *(const PG8_LAS bf16x8*)(lds + PG8_SB(b, h) + boff + n * 2048 + k * 1024); } while (0)
#define PG8_MMA(ai, bj, At, Bt) do { __builtin_amdgcn_s_setprio(1); _Pragma("unroll") for (int m = 0; m < 4; ++m) _Pragma("unroll") for (int n = 0; n < 2; ++n) _Pragma("unroll") for (int k = 0; k < 2; ++k) \
        acc[ai][bj][m][n] = __builtin_amdgcn_mfma_f32_16x16x32_bf16(Bt[n][k], At[m][k], acc[ai][bj][m][n], 0, 0, 0); __builtin_amdgcn_s_setprio(0); } while (0)
#define PG8_WAIT_V(n) asm volatile("s_waitcnt vmcnt(" #n ")" ::: "memory")
#define PG8_WAIT_L(n) asm volatile("s_waitcnt lgkmcnt(" #n ")" ::: "memory")
#define PG8_BAR __builtin_amdgcn_s_barrier()
#define PG8_SCHED __builtin_amdgcn_sched_barrier(0)
    Unit cur, nxt; int ui = 0;
    if (!S.next(0, cur)) return;
    f32x4 acc[2][2][4][2];
#pragma unroll
    for (int a = 0; a < 2; ++a)
#pragma unroll
        for (int b = 0; b < 2; ++b)
#pragma unroll
            for (int m = 0; m < 4; ++m)
#pragma unroll
                for (int n = 0; n < 2; ++n) acc[a][b][m][n] = (f32x4){0.f, 0.f, 0.f, 0.f};
    bf16x8 At[4][2], B0[2][2], B1[2][2];
    const char* cA = (const char*)g.A + (size_t)cur.pm * tstepA; const char* cB = (const char*)g.Bt + (size_t)cur.pn * tstepB;
    S.a_ready(cur);
    if constexpr (SP2) {
        PG8_STAGE(PG8_SB(0, 0), cB, voffB); PG8_STAGE(PG8_SB(0, 1), cB + hstepB, voffB); PG8_STAGE(PG8_SA(0, 0), cA, voffA); PG8_STAGE(PG8_SA(0, 1), cA + hstepA, voffA);
        if (wr == 1) PG8_BAR;
        PG8_WAIT_V(2); PG8_BAR;
        PG8_STAGE(PG8_SB(1, 0), cB + kstep, voffB); PG8_STAGE(PG8_SA(1, 0), cA + kstep, voffA); PG8_STAGE(PG8_SB(1, 1), cB + hstepB + kstep, voffB);
        PG8_WAIT_V(6); PG8_BAR;
    } else {
        PG8_STAGE(PG8_SB(0, 0), cB, voffB); PG8_STAGE(PG8_SA(0, 0), cA, voffA); PG8_STAGE(PG8_SB(0, 1), cB + hstepB, voffB); PG8_STAGE(PG8_SA(0, 1), cA + hstepA, voffA);
        if (wr == 1) PG8_BAR;
        PG8_WAIT_V(4); PG8_BAR;
        PG8_STAGE(PG8_SB(1, 0), cB + kstep, voffB); PG8_STAGE(PG8_SA(1, 0), cA + kstep, voffA); PG8_STAGE(PG8_SB(1, 1), cB + hstepB + kstep, voffB);
        PG8_WAIT_V(6); PG8_BAR;
    }
    for (;;) {
        const bool has_next = S.next(ui + 1, nxt);
        const char* nA = has_next ? (const char*)g.A + (size_t)nxt.pm * tstepA : cA; const char* nB = has_next ? (const char*)g.Bt + (size_t)nxt.pn * tstepB : cB;
        for (int t = 0; t < nt; t += 2) {
            if constexpr (Epi::HAS_MID) { if (t == E.mid_t) E.mid(acc, cur, wr, wc, fr, fq); }
            const bool last = (t == nt - 2);
            const char* a1 = cA + (size_t)(t + 1) * kstep;
            const char* a2 = last ? nA : cA + (size_t)(t + 2) * kstep; const char* b2 = last ? nB : cB + (size_t)(t + 2) * kstep;
            const char* a3 = a2 + kstep; const char* b3 = b2 + kstep;
            if (last && has_next) S.a_ready(nxt);
            if constexpr (SP2) {
            PG8_LDB(B0, 0, 0); PG8_LDB(B1, 0, 1); PG8_SCHED; PG8_LDA(At, 0, 0); PG8_STAGE(PG8_SA(1, 1), a1 + hstepA, voffA);
            PG8_WAIT_V(8); PG8_WAIT_L(0); PG8_BAR; PG8_MMA(0, 0, At, B0); PG8_MMA(0, 1, At, B1); PG8_BAR; PG8_SCHED;
            PG8_LDA(At, 0, 1); PG8_STAGE(PG8_SB(0, 0), b2, voffB); PG8_STAGE(PG8_SB(0, 1), b2 + hstepB, voffB); PG8_STAGE(PG8_SA(0, 0), a2, voffA);
            PG8_WAIT_V(8); PG8_WAIT_L(0); PG8_BAR; PG8_MMA(1, 0, At, B0); PG8_MMA(1, 1, At, B1); PG8_BAR; PG8_SCHED;
            PG8_LDB(B0, 1, 0); PG8_LDB(B1, 1, 1); PG8_SCHED; PG8_LDA(At, 1, 0); PG8_STAGE(PG8_SA(0, 1), a2 + hstepA, voffA);
            PG8_WAIT_V(8); PG8_WAIT_L(0); PG8_BAR; PG8_MMA(0, 0, At, B0); PG8_MMA(0, 1, At, B1); PG8_BAR; PG8_SCHED;
            PG8_LDA(At, 1, 1); PG8_STAGE(PG8_SB(1, 0), b3, voffB); PG8_STAGE(PG8_SB(1, 1), b3 + hstepB, voffB); PG8_STAGE(PG8_SA(1, 0), a3, voffA);
            PG8_WAIT_V(8); PG8_WAIT_L(0); PG8_BAR; PG8_MMA(1, 0, At, B0); PG8_MMA(1, 1, At, B1); PG8_BAR; PG8_SCHED;
            } else {
            PG8_LDB(B0, 0, 0); PG8_SCHED; PG8_LDA(At, 0, 0); PG8_STAGE(PG8_SA(1, 1), a1 + hstepA, voffA);
            PG8_WAIT_L(8); PG8_BAR; PG8_WAIT_L(0); PG8_MMA(0, 0, At, B0); PG8_BAR; PG8_SCHED;
            PG8_LDB(B1, 0, 1); PG8_STAGE(PG8_SB(0, 0), b2, voffB);
            PG8_BAR; PG8_WAIT_L(0); PG8_MMA(0, 1, At, B1); PG8_BAR;
            PG8_LDA(At, 0, 1); PG8_STAGE(PG8_SA(0, 0), a2, voffA);
            PG8_BAR; PG8_WAIT_L(0); PG8_MMA(1, 0, At, B0); PG8_BAR; PG8_SCHED;
            PG8_STAGE(PG8_SB(0, 1), b2 + hstepB, voffB);
            PG8_WAIT_V(6); PG8_BAR; PG8_MMA(1, 1, At, B1); PG8_BAR;
            PG8_LDB(B0, 1, 0); PG8_SCHED; PG8_LDA(At, 1, 0); PG8_STAGE(PG8_SA(0, 1), a2 + hstepA, voffA);
            PG8_WAIT_L(8); PG8_BAR; PG8_WAIT_L(0); PG8_MMA(0, 0, At, B0); PG8_BAR; PG8_SCHED;
            PG8_LDB(B1, 1, 1); PG8_STAGE(PG8_SB(1, 0), b3, voffB);
            PG8_BAR; PG8_WAIT_L(0); PG8_MMA(0, 1, At, B1); PG8_BAR;
            PG8_LDA(At, 1, 1); PG8_STAGE(PG8_SA(1, 0), a3, voffA);
            PG8_BAR; PG8_WAIT_L(0); PG8_MMA(1, 0, At, B0); PG8_BAR; PG8_SCHED;
            PG8_STAGE(PG8_SB(1, 1), b3 + hstepB, voffB);
            PG8_WAIT_V(6); PG8_BAR; PG8_MMA(1, 1, At, B1); PG8_BAR;
            }
        }
        if constexpr (ALIGN_EPI) { if (wr == 0) PG8_BAR; }
        if constexpr (!Epi::AFTER_DRAIN) { E(acc, cur, wr, wc, fr, fq); S.done(cur); }
        if (!has_next) break;
#pragma unroll
        for (int a = 0; a < 2; ++a)
#pragma unroll
            for (int b = 0; b < 2; ++b)
#pragma unroll
                for (int m = 0; m < 4; ++m)
#pragma unroll
                    for (int n = 0; n < 2; ++n) acc[a][b][m][n] = (f32x4){0.f, 0.f, 0.f, 0.f};
        cur = nxt; cA = nA; cB = nB; ++ui;
        if constexpr (ALIGN_EPI) { if (wr == 1) PG8_BAR; }
    }
    PG8_WAIT_V(0);
    if constexpr (!ALIGN_EPI) { if (wr == 0) PG8_BAR; }
    PG8_BAR;
    if constexpr (Epi::AFTER_DRAIN) { E.fused(acc, cur, wr, wc, fr, fq, lds, wid, lane); S.done(cur); }
#undef PG8_SA
#undef PG8_SB
#undef PG8_STAGE
#undef PG8_LDA
#undef PG8_LDB
#undef PG8_MMA
#undef PG8_WAIT_V
#undef PG8_WAIT_L
#undef PG8_BAR
#undef PG8_SCHED
}
}

#define LAS __attribute__((address_space(3)))
typedef unsigned short bf16;
typedef float f32x4 __attribute__((ext_vector_type(4)));
typedef short bf16x8 __attribute__((ext_vector_type(8)));
typedef short bf16x4 __attribute__((ext_vector_type(4)));
typedef unsigned u32x4 __attribute__((ext_vector_type(4)));
typedef unsigned u32x2 __attribute__((ext_vector_type(2)));
using pg8::cvtpk; using pg8::bflo; using pg8::bfhi; using pg8::siluf_; using pg8::sigmoidf_;
constexpr int NWAVES = 8, NTHR = 512;
constexpr int M = 16384, MB = 8192, DMODEL = 1024, DFF = 2816;
constexpr int LDP = 8704;
constexpr int PC_Q = 0, PC_Z = 1024, PC_K = 3072, PC_V = 3328, PC_XBC = 3584, PC_GA = 6656, PC_GS = 7680;
constexpr int NPROJ = 8960;
constexpr float LN_EPS = 1e-5f, RMS_EPS = 1e-5f;
constexpr float ALPHA = 1.189207115002721f;
constexpr size_t MiB = 1u << 20;
constexpr size_t WS_DEC = 512 * 1024, WS_DT = 1 * MiB, WS_WGU = 2 * MiB, WS_WD = 13 * MiB, WS_WIN = 19 * MiB, WS_WCAT = 37 * MiB, WS_WOUT = 43 * MiB, WS_X1F = 45 * MiB, WS_BIG = 109 * MiB, WS_END = 245 * MiB;
constexpr size_t DO_XB = 0, DO_ST = 32 * MiB;
constexpr int LDS_BYTES = 147456;

#define LDS_WAIT() asm volatile("s_waitcnt lgkmcnt(0)" ::: "memory")
#define MFMA16(a, b, c) __builtin_amdgcn_mfma_f32_16x16x32_bf16((a), (b), (c), 0, 0, 0)

__device__ __forceinline__ float wave_sum(float v) {
#pragma unroll
    for (int o = 1; o < 64; o <<= 1) v += __shfl_xor(v, o);
    return v;
}
__device__ __forceinline__ void tr_item(const float* W, int ldw, int k0, int n0, bf16* WT, int ldt, int drow, int dcol, LAS float* scr, int lane) {
#pragma unroll 8
    for (int i = 0; i < 32; ++i) { const int kk = 2 * i + (lane >> 5); scr[kk * 33 + (lane & 31)] = W[(size_t)(k0 + kk) * ldw + n0 + (lane & 31)]; }
    LDS_WAIT(); asm volatile("" ::: "memory");
    const int c = lane & 7;
#pragma unroll
    for (int j = 0; j < 4; ++j) { const int n = (lane >> 3) + 8 * j; const LAS float* s = scr + (8 * c) * 33 + n;
        u32x4 o; o.x = cvtpk(s[0 * 33], s[1 * 33]); o.y = cvtpk(s[2 * 33], s[3 * 33]); o.z = cvtpk(s[4 * 33], s[5 * 33]); o.w = cvtpk(s[6 * 33], s[7 * 33]);
        *(u32x4*)(WT + (size_t)(drow + n) * ldt + dcol + 8 * c) = o; }
    LDS_WAIT(); asm volatile("" ::: "memory");
}
__device__ __forceinline__ int map_in(int n0) {
    if (n0 < 1024) return n0;
    if (n0 < 1280) return PC_K + (n0 - 1024);
    if (n0 < 1536) return PC_V + (n0 - 1280);
    if (n0 < 3584) return PC_Z + (n0 - 1536);
    if (n0 < 6656) return n0;
    if (n0 < 6688) return 8704 + (n0 - 6656);
    if (n0 < 7712) return PC_GA + (n0 - 6688);
    return PC_GS + (n0 - 7712);
}
__device__ __forceinline__ void ffn_weight_items(const float* wg, const float* wu, const float* wd, bf16* Wgu, bf16* Wd, LAS float* scr, int gw, int NGW, int lane) {
    constexpr int I_G = 16 * 88, I_D = 44 * 32;
    for (int it = gw; it < 2 * I_G + I_D; it += NGW) {
        int r = it;
        if (r < 2 * I_G) { const bool up = r >= I_G; if (up) r -= I_G; const int kb = r / 88, nb = r % 88, n0 = nb * 32;
            tr_item(up ? wu : wg, DFF, kb * 64, n0, Wgu, 1024, (n0 >> 7) * 256 + (n0 & 127) + (up ? 128 : 0), kb * 64, scr, lane); continue; }
        r -= 2 * I_G; { const int kb = r / 32, nb = r % 32; tr_item(wd, 1024, kb * 64, nb * 32, Wd, DFF, nb * 32, kb * 64, scr, lane); }
    }
}
__device__ __forceinline__ void ln_rows(const float* src, float* dstf, bf16* dstb, const float* g, const float* b, int nrows, int gw, int NGW, int lane) {
    f32x4 gv[4], bv[4];
#pragma unroll
    for (int j = 0; j < 4; ++j) { gv[j] = *((const f32x4*)g + lane + 64 * j); bv[j] = *((const f32x4*)b + lane + 64 * j); }
    for (int m = gw; m < nrows; m += NGW) {
        const f32x4* xr = (const f32x4*)(src + (size_t)m * 1024) + lane;
        f32x4 v[4]; float s = 0.f;
#pragma unroll
        for (int j = 0; j < 4; ++j) { v[j] = xr[64 * j]; s += (v[j].x + v[j].y) + (v[j].z + v[j].w); }
        const float mean = wave_sum(s) * (1.f / 1024.f); float s2 = 0.f;
#pragma unroll
        for (int j = 0; j < 4; ++j) { v[j] = v[j] - mean; s2 += (v[j].x * v[j].x + v[j].y * v[j].y) + (v[j].z * v[j].z + v[j].w * v[j].w); }
        const float rstd = 1.f / sqrtf(wave_sum(s2) * (1.f / 1024.f) + LN_EPS);
#pragma unroll
        for (int j = 0; j < 4; ++j) { const f32x4 y = v[j] * rstd * gv[j] + bv[j];
            if (dstf) *((f32x4*)(dstf + (size_t)m * 1024) + lane + 64 * j) = y;
            if (dstb) { u32x2 w; w.x = cvtpk(y.x, y.y); w.y = cvtpk(y.z, y.w); *((u32x2*)(dstb + (size_t)m * 1024) + lane + 64 * j) = w; } }
    }
}
struct ConvW { f32x4 w[4][2]; f32x4 b[2]; };
__device__ __forceinline__ void conv_load_w(ConvW& cw, const float* conv_w, const float* conv_b, int xch) {
#pragma unroll
    for (int j = 0; j < 4; ++j) { cw.w[j][0] = *(const f32x4*)(conv_w + j * 3072 + xch); cw.w[j][1] = *(const f32x4*)(conv_w + j * 3072 + xch + 4); }
    cw.b[0] = *(const f32x4*)(conv_b + xch); cw.b[1] = *(const f32x4*)(conv_b + xch + 4);
}
__device__ __forceinline__ void conv8(const bf16* P, int row, int xch, const ConvW& cw, float (&o)[8]) {
    f32x4 a0 = cw.b[0], a1 = cw.b[1];
#pragma unroll
    for (int j = 0; j < 4; ++j) { const int r = row - 3 + j;
        if (r >= 0) { const u32x4 v = *(const u32x4*)(P + (size_t)r * LDP + PC_XBC + xch);
            a0[0] += cw.w[j][0][0] * bflo(v.x); a0[1] += cw.w[j][0][1] * bfhi(v.x); a0[2] += cw.w[j][0][2] * bflo(v.y); a0[3] += cw.w[j][0][3] * bfhi(v.y);
            a1[0] += cw.w[j][1][0] * bflo(v.z); a1[1] += cw.w[j][1][1] * bfhi(v.z); a1[2] += cw.w[j][1][2] * bflo(v.w); a1[3] += cw.w[j][1][3] * bfhi(v.w); } }
#pragma unroll
    for (int i = 0; i < 4; ++i) { o[i] = siluf_(a0[i]); o[4 + i] = siluf_(a1[i]); }
}
__device__ __forceinline__ void chunk_decay(const float* dtbuf, int row0, int head, float bias, float Aneg, int lane, float& dt0, float& dt1, float& ac0, float& ac1) {
    float r0 = dtbuf[(size_t)(row0 + 2 * lane) * 32 + head] + bias, r1 = dtbuf[(size_t)(row0 + 2 * lane + 1) * 32 + head] + bias;
    dt0 = fmaxf(r0, 0.f) + log1pf(__expf(-fabsf(r0))); dt1 = fmaxf(r1, 0.f) + log1pf(__expf(-fabsf(r1)));
    const float a0 = dt0 * Aneg, a1 = dt1 * Aneg;
    float s = a0 + a1;
#pragma unroll
    for (int o = 1; o < 64; o <<= 1) { const float t = __shfl_up(s, o); if (lane >= o) s += t; }
    ac1 = s; ac0 = s - a1;
}
constexpr int AT_QS = 0, AT_KS = 18432, AT_VT = 55296, AT_PS = 91136, AT_END = AT_PS + 8 * 16 * 336;
static_assert(AT_END <= 147456, "attention LDS");
__device__ __forceinline__ void attn_unit(LAS unsigned char* lds, bf16* P, int blk, int h, float sink, int tid_in) {
    int tid = tid_in; asm volatile("" : "+v"(tid));
    const int lane = tid & 63, w = __builtin_amdgcn_readfirstlane(tid >> 6), fr = lane & 15, kg = lane >> 4;
    const int row0 = blk * 128, g = h >> 2;
#pragma unroll
    for (int i = 0; i < 2; ++i) { const int idx = tid + 512 * i, r = idx >> 3, ch = idx & 7;
        const u32x4 v = *(const u32x4*)(P + (size_t)(row0 + r) * LDP + PC_Q + h * 64 + ch * 8); *(LAS u32x4*)(lds + AT_QS + r * 144 + ch * 16) = v; }
#pragma unroll
    for (int i = 0; i < 4; ++i) { const int idx = tid + 512 * i, kj = idx >> 3, ch = idx & 7; const int srow = (blk > 0) ? row0 - 128 + kj : row0 + (kj & 127);
        const u32x4 v = *(const u32x4*)(P + (size_t)srow * LDP + PC_K + g * 64 + ch * 8); *(LAS u32x4*)(lds + AT_KS + kj * 144 + ch * 16) = v; }
#pragma unroll
    for (int i = 0; i < 4; ++i) { const int idx = tid + 512 * i, kj = idx & 255, ch = idx >> 8; const int srow = (blk > 0) ? row0 - 128 + kj : row0 + (kj & 127);
        const u32x4 v = *(const u32x4*)(P + (size_t)srow * LDP + PC_V + g * 64 + ch * 8);
        LAS unsigned short* d = (LAS unsigned short*)(lds + AT_VT + (ch * 8) * 560 + kj * 2);
        d[0 * 280] = (unsigned short)(v.x & 0xffffu); d[1 * 280] = (unsigned short)(v.x >> 16); d[2 * 280] = (unsigned short)(v.y & 0xffffu); d[3 * 280] = (unsigned short)(v.y >> 16);
        d[4 * 280] = (unsigned short)(v.z & 0xffffu); d[5 * 280] = (unsigned short)(v.z >> 16); d[6 * 280] = (unsigned short)(v.w & 0xffffu); d[7 * 280] = (unsigned short)(v.w >> 16); }
    for (int idx = tid; idx < 64 * 12; idx += 512) { const int d = idx / 12, wv = idx % 12; *(LAS unsigned*)(lds + AT_VT + d * 560 + 512 + wv * 4) = 0u; }
    { const int row = lane >> 2, part = lane & 3; *(LAS u32x2*)(lds + AT_PS + w * 5376 + row * 336 + 288 + part * 8) = (u32x2){0u, 0u}; }
    __syncthreads();
    bf16x8 qf[2];
#pragma unroll
    for (int ks = 0; ks < 2; ++ks) qf[ks] = *(const LAS bf16x8*)(lds + AT_QS + (16 * w + fr) * 144 + (32 * ks + 8 * kg) * 2);
    f32x4 s[9];
#pragma unroll
    for (int ti = 0; ti < 9; ++ti) { const int t = w + ti; f32x4 acc = {0.f, 0.f, 0.f, 0.f};
#pragma unroll
        for (int ks = 0; ks < 2; ++ks) { const bf16x8 kf = *(const LAS bf16x8*)(lds + AT_KS + (16 * t + fr) * 144 + (32 * ks + 8 * kg) * 2); acc = MFMA16(kf, qf[ks], acc); }
        s[ti] = acc; }
    const int qi = 128 + 16 * w + fr; float mx = sink;
#pragma unroll
    for (int ti = 0; ti < 9; ++ti)
#pragma unroll
        for (int j = 0; j < 4; ++j) { const int kj = 16 * (w + ti) + 4 * kg + j, d = qi - kj; const bool valid = (d >= 0) && (d < 128) && (blk > 0 || kj >= 128);
            const float v = valid ? s[ti][j] * 0.125f : -INFINITY; s[ti][j] = v; mx = fmaxf(mx, v); }
    mx = fmaxf(mx, __shfl_xor(mx, 16)); mx = fmaxf(mx, __shfl_xor(mx, 32));
    float sum = 0.f;
#pragma unroll
    for (int ti = 0; ti < 9; ++ti) {
#pragma unroll
        for (int j = 0; j < 4; ++j) { const float p = __expf(s[ti][j] - mx); s[ti][j] = p; sum += p; }
        u32x2 pw; pw.x = cvtpk(s[ti][0], s[ti][1]); pw.y = cvtpk(s[ti][2], s[ti][3]);
        *(LAS u32x2*)(lds + AT_PS + w * 5376 + fr * 336 + (16 * ti + 4 * kg) * 2) = pw; }
    sum += __shfl_xor(sum, 16); sum += __shfl_xor(sum, 32);
    const float inv = 1.0f / (sum + __expf(sink - mx));
    LDS_WAIT(); asm volatile("" ::: "memory");
    f32x4 o[4];
#pragma unroll
    for (int dt = 0; dt < 4; ++dt) o[dt] = (f32x4){0.f, 0.f, 0.f, 0.f};
#pragma unroll
    for (int ks = 0; ks < 5; ++ks) { const bf16x8 pf = *(const LAS bf16x8*)(lds + AT_PS + w * 5376 + fr * 336 + (32 * ks + 8 * kg) * 2);
#pragma unroll
        for (int dt = 0; dt < 4; ++dt) { const bf16x8 vf = *(const LAS bf16x8*)(lds + AT_VT + (16 * dt + fr) * 560 + (16 * w + 32 * ks + 8 * kg) * 2); o[dt] = MFMA16(vf, pf, o[dt]); } }
    bf16* orow = P + (size_t)(row0 + 16 * w + fr) * LDP + PC_Q + h * 64 + 4 * kg;
#pragma unroll
    for (int dt = 0; dt < 4; ++dt) { u32x2 ow; ow.x = cvtpk(o[dt][0] * inv, o[dt][1] * inv); ow.y = cvtpk(o[dt][2] * inv, o[dt][3] * inv); *(u32x2*)(orow + 16 * dt) = ow; }
    __syncthreads();
}

constexpr int S1_BT = 0, S1_XW = 34816, S1_SW = 104448;
__device__ __forceinline__ void s1_unit(LAS unsigned char* lds, const bf16* P, const float* dtbuf, float* dec, bf16* states, int c, int g,
                                        const float* conv_w, const float* conv_b, const float* dt_bias, const float* a_log, int tid_in) {
    int tid = tid_in; asm volatile("" : "+v"(tid));
    const int lane = tid & 63, w = __builtin_amdgcn_readfirstlane(tid >> 6), fr = lane & 15, kg = lane >> 4;
    const int row0 = c * 128;
    { const int hh = 8 * g + w; const float Aneg = -__expf(a_log[hh]); float dt0, dt1, ac0, ac1;
      chunk_decay(dtbuf, row0, hh, dt_bias[hh], Aneg, lane, dt0, dt1, ac0, ac1);
      const float tot = __shfl(ac1, 63);
      LAS float* sw = (LAS float*)(lds + S1_SW) + w * 128;
      sw[2 * lane] = __expf(tot - ac0) * dt0; sw[2 * lane + 1] = __expf(tot - ac1) * dt1;
      if (lane == 63) dec[c * 32 + hh] = __expf(tot); }
    { const int ch = tid >> 5, xch = 2048 + g * 128 + ch * 8; ConvW cw; conv_load_w(cw, conv_w, conv_b, xch);
#pragma unroll 1
      for (int i = 0; i < 4; ++i) { const int l = (tid & 31) + 32 * i; float o[8]; conv8(P, row0 + l, xch, cw, o);
          LAS unsigned short* d = (LAS unsigned short*)(lds + S1_BT + (ch * 8) * 272 + l * 2);
#pragma unroll
          for (int e = 0; e < 8; e += 2) { const unsigned pw = cvtpk(o[e], o[e + 1]); d[e * 136] = (unsigned short)(pw & 0xffffu); d[(e + 1) * 136] = (unsigned short)(pw >> 16); } } }
#pragma unroll 1
    for (int half = 0; half < 2; ++half) {
        __syncthreads();
        { const int ch = tid >> 4, xch = g * 512 + half * 256 + ch * 8; const int hl = half * 4 + (ch >> 3); ConvW cw; conv_load_w(cw, conv_w, conv_b, xch);
          const LAS float* sw = (const LAS float*)(lds + S1_SW) + hl * 128;
#pragma unroll 1
          for (int i = 0; i < 8; ++i) { const int l = (tid & 15) + 16 * i; float o[8]; conv8(P, row0 + l, xch, cw, o); const float wv = sw[l];
              LAS unsigned short* d = (LAS unsigned short*)(lds + S1_XW + (ch * 8) * 272 + l * 2);
#pragma unroll
              for (int e = 0; e < 8; e += 2) { const unsigned pw = cvtpk(o[e] * wv, o[e + 1] * wv); d[e * 136] = (unsigned short)(pw & 0xffffu); d[(e + 1) * 136] = (unsigned short)(pw >> 16); } } }
        __syncthreads();
        const int hl = w >> 1, ph = w & 1;
        f32x4 acc[2][8];
#pragma unroll
        for (int pt = 0; pt < 2; ++pt)
#pragma unroll
            for (int nt = 0; nt < 8; ++nt) acc[pt][nt] = (f32x4){0.f, 0.f, 0.f, 0.f};
#pragma unroll
        for (int ks = 0; ks < 4; ++ks) { bf16x8 xf[2];
#pragma unroll
            for (int pt = 0; pt < 2; ++pt) xf[pt] = *(const LAS bf16x8*)(lds + S1_XW + (hl * 64 + ph * 32 + 16 * pt + fr) * 272 + (32 * ks + 8 * kg) * 2);
#pragma unroll
            for (int nt = 0; nt < 8; ++nt) { const bf16x8 bfr = *(const LAS bf16x8*)(lds + S1_BT + (16 * nt + fr) * 272 + (32 * ks + 8 * kg) * 2);
#pragma unroll
                for (int pt = 0; pt < 2; ++pt) acc[pt][nt] = MFMA16(bfr, xf[pt], acc[pt][nt]); } }
        const int hh = 8 * g + half * 4 + hl;
#pragma unroll
        for (int pt = 0; pt < 2; ++pt) { bf16* sp = states + ((size_t)(c * 32 + hh) * 64 + ph * 32 + 16 * pt + fr) * 128 + 4 * kg;
#pragma unroll
            for (int nt = 0; nt < 8; ++nt) { u32x2 ow; ow.x = cvtpk(acc[pt][nt][0], acc[pt][nt][1]); ow.y = cvtpk(acc[pt][nt][2], acc[pt][nt][3]); *(u32x2*)(sp + 16 * nt) = ow; } }
    }
    __syncthreads();
}
__device__ __forceinline__ void scan_phase(bf16* states, const float* dec, int gtid, int nthr) {
    for (int e = gtid; e < 131072; e += nthr) { const int head = e >> 12; unsigned* p = (unsigned*)states + (size_t)head * 4096 + (e & 4095);
        float h0 = 0.f, h1 = 0.f;
#pragma unroll 8
        for (int c = 0; c < 64; ++c) { const float d = dec[c * 32 + head]; const unsigned v = p[(size_t)c * 131072]; p[(size_t)c * 131072] = cvtpk(h0, h1); h0 = d * h0 + bflo(v); h1 = d * h1 + bfhi(v); } }
}
constexpr int S3_CS = 0, S3_R = 34816, S3_AC = 104448, S3_DT = 108544;
__device__ __forceinline__ void s3_unit(LAS unsigned char* lds, bf16* P, const float* dtbuf, const bf16* states, int c, int g,
                                        const float* conv_w, const float* conv_b, const float* dt_bias, const float* a_log, const float* d_skip, const float* norm_w, int tid_in) {
    int tid = tid_in; asm volatile("" : "+v"(tid));
    const int lane = tid & 63, w = __builtin_amdgcn_readfirstlane(tid >> 6), fr = lane & 15, kg = lane >> 4;
    const int row0 = c * 128;
    { const int hh = 8 * g + w; const float Aneg = -__expf(a_log[hh]); float dt0, dt1, ac0, ac1;
      chunk_decay(dtbuf, row0, hh, dt_bias[hh], Aneg, lane, dt0, dt1, ac0, ac1);
      LAS float* ac = (LAS float*)(lds + S3_AC) + w * 128; LAS float* dv = (LAS float*)(lds + S3_DT) + w * 128;
      ac[2 * lane] = ac0; ac[2 * lane + 1] = ac1; dv[2 * lane] = dt0; dv[2 * lane + 1] = dt1; }
#pragma unroll 1
    for (int which = 0; which < 2; ++which) { const int ch = tid & 15, xch = (which ? 2048 : 2560) + g * 128 + ch * 8; ConvW cw; conv_load_w(cw, conv_w, conv_b, xch);
        const int base = which ? S3_R : S3_CS;
#pragma unroll 1
        for (int i = 0; i < 4; ++i) { const int l = (tid >> 4) + 32 * i; float o[8]; conv8(P, row0 + l, xch, cw, o);
            u32x4 pw; pw.x = cvtpk(o[0], o[1]); pw.y = cvtpk(o[2], o[3]); pw.z = cvtpk(o[4], o[5]); pw.w = cvtpk(o[6], o[7]);
            *(LAS u32x4*)(lds + base + l * 272 + ch * 16) = pw; } }
    __syncthreads();
    bf16x8 cf[4];
#pragma unroll
    for (int ks = 0; ks < 4; ++ks) cf[ks] = *(const LAS bf16x8*)(lds + S3_CS + (16 * w + fr) * 272 + (32 * ks + 8 * kg) * 2);
    f32x4 cb[8];
#pragma unroll
    for (int ts = 0; ts < 8; ++ts) { f32x4 acc = {0.f, 0.f, 0.f, 0.f};
        if (ts <= w) {
#pragma unroll
            for (int ks = 0; ks < 4; ++ks) { const bf16x8 bfr = *(const LAS bf16x8*)(lds + S3_R + (16 * ts + fr) * 272 + (32 * ks + 8 * kg) * 2); acc = MFMA16(bfr, cf[ks], acc); } }
        cb[ts] = acc; }
    float ssq[4] = {0.f, 0.f, 0.f, 0.f};
    const int lme = 16 * w + fr;
#pragma unroll 1
    for (int hidx = 0; hidx < 8; ++hidx) {
        if ((hidx & 3) == 0) {
            __syncthreads();
            { const int half = hidx >> 2; const int ch = tid >> 4, xch = g * 512 + half * 256 + ch * 8; ConvW cw; conv_load_w(cw, conv_w, conv_b, xch);
#pragma unroll 1
              for (int i = 0; i < 8; ++i) { const int l = (tid & 15) + 16 * i; float o[8]; conv8(P, row0 + l, xch, cw, o);
                  LAS unsigned short* d = (LAS unsigned short*)(lds + S3_R + (ch * 8) * 272 + l * 2);
#pragma unroll
                  for (int e = 0; e < 8; e += 2) { const unsigned pw = cvtpk(o[e], o[e + 1]); d[e * 136] = (unsigned short)(pw & 0xffffu); d[(e + 1) * 136] = (unsigned short)(pw >> 16); } } }
            __syncthreads();
        }
        const int hl = hidx & 3, hh = 8 * g + hidx;
        const LAS float* ac = (const LAS float*)(lds + S3_AC) + hidx * 128; const LAS float* dv = (const LAS float*)(lds + S3_DT) + hidx * 128;
        const float acl = ac[lme];
        f32x4 accD[4], accO[4];
#pragma unroll
        for (int pt = 0; pt < 4; ++pt) { accD[pt] = (f32x4){0.f, 0.f, 0.f, 0.f}; accO[pt] = (f32x4){0.f, 0.f, 0.f, 0.f}; }
#pragma unroll
        for (int ks = 0; ks < 4; ++ks) {
            if (2 * ks <= w) { float mv[8];
#pragma unroll
                for (int tsub = 0; tsub < 2; ++tsub) { const int ts = 2 * ks + tsub; const f32x4 as = *(const LAS f32x4*)(ac + 16 * ts + 4 * kg), ds = *(const LAS f32x4*)(dv + 16 * ts + 4 * kg);
#pragma unroll
                    for (int j = 0; j < 4; ++j) { const int sidx = 16 * ts + 4 * kg + j; mv[4 * tsub + j] = (sidx <= lme) ? cb[ts][j] * __expf(acl - as[j]) * ds[j] : 0.f; } }
                u32x4 mw; mw.x = cvtpk(mv[0], mv[1]); mw.y = cvtpk(mv[2], mv[3]); mw.z = cvtpk(mv[4], mv[5]); mw.w = cvtpk(mv[6], mv[7]);
                const bf16x8 mf = __builtin_bit_cast(bf16x8, mw);
#pragma unroll
                for (int pt = 0; pt < 4; ++pt) { const int chan = hl * 64 + 16 * pt + fr;
                    const u32x2 lo = *(const LAS u32x2*)(lds + S3_R + chan * 272 + (32 * ks + 4 * kg) * 2), hi = *(const LAS u32x2*)(lds + S3_R + chan * 272 + (32 * ks + 16 + 4 * kg) * 2);
                    const u32x4 xw = {lo.x, lo.y, hi.x, hi.y}; accD[pt] = MFMA16(mf, __builtin_bit_cast(bf16x8, xw), accD[pt]); } } }
#pragma unroll
        for (int pt = 0; pt < 4; ++pt) { const bf16* pp = states + ((size_t)(c * 32 + hh) * 64 + 16 * pt + fr) * 128 + 8 * kg;
#pragma unroll
            for (int ks = 0; ks < 4; ++ks) { const bf16x8 pf = *(const bf16x8*)(pp + 32 * ks); accO[pt] = MFMA16(cf[ks], pf, accO[pt]); }
            asm volatile("" ::: "memory"); }
        const f32x4 al = *(const LAS f32x4*)(ac + 16 * w + 4 * kg); f32x4 ea;
#pragma unroll
        for (int j = 0; j < 4; ++j) ea[j] = __expf(al[j]);
        const float Dh = d_skip[hh];
#pragma unroll
        for (int pt = 0; pt < 4; ++pt) { const u32x2 xv = *(const LAS u32x2*)(lds + S3_R + (hl * 64 + 16 * pt + fr) * 272 + (16 * w + 4 * kg) * 2);
            const float xs[4] = {bflo(xv.x), bfhi(xv.x), bflo(xv.y), bfhi(xv.y)};
            bf16* zp = P + (size_t)(row0 + 16 * w + 4 * kg) * LDP + PC_Z + hh * 64 + 16 * pt + fr;
#pragma unroll
            for (int j = 0; j < 4; ++j) { const float y = accD[pt][j] + ea[j] * accO[pt][j] + Dh * xs[j]; const float z = __uint_as_float((unsigned)zp[(size_t)j * LDP] << 16);
                const unsigned ub = cvtpk(y * siluf_(z), 0.f) & 0xffffu; const float ur = __uint_as_float(ub << 16); ssq[j] += ur * ur; zp[(size_t)j * LDP] = (bf16)ub; } }
    }
    float rs[4];
#pragma unroll
    for (int j = 0; j < 4; ++j) { float v = ssq[j]; v += __shfl_xor(v, 1); v += __shfl_xor(v, 2); v += __shfl_xor(v, 4); v += __shfl_xor(v, 8); rs[j] = 1.0f / sqrtf(v * (1.0f / 512.0f) + RMS_EPS); }
#pragma unroll 1
    for (int hidx = 0; hidx < 8; ++hidx)
#pragma unroll
        for (int pt = 0; pt < 4; ++pt) { const int col = (8 * g + hidx) * 64 + 16 * pt + fr; const float nw = norm_w[col];
            bf16* up = P + (size_t)(row0 + 16 * w + 4 * kg) * LDP + PC_Z + col;
#pragma unroll
            for (int j = 0; j < 4; ++j) { const float u = __uint_as_float((unsigned)up[(size_t)j * LDP] << 16); up[(size_t)j * LDP] = (bf16)(cvtpk(u * rs[j] * nw, 0.f) & 0xffffu); } }
    __syncthreads();
}
struct Args { const float* in[24]; float* out; unsigned char* ws; };
__global__ void __launch_bounds__(NTHR, 2) mega_fwd(Args a) {
    extern __shared__ __attribute__((aligned(16))) unsigned char lds_raw[];
    LAS unsigned char* lds = (LAS unsigned char*)lds_raw;
    cg::grid_group grid = cg::this_grid();
    const int tid = threadIdx.x, lane = tid & 63, wave = __builtin_amdgcn_readfirstlane(tid >> 6);
    const int G = gridDim.x, bid = blockIdx.x, gw = bid * NWAVES + wave, NGW = G * NWAVES, gtid = bid * NTHR + tid, nthr = G * NTHR;
    unsigned char* ws = a.ws; unsigned char* dob = (unsigned char*)a.out;
    const float* x = a.in[0];
    bf16* Wgu = (bf16*)(ws + WS_WGU); bf16* Wd = (bf16*)(ws + WS_WD); bf16* Win = (bf16*)(ws + WS_WIN); bf16* Wcat = (bf16*)(ws + WS_WCAT); bf16* Wout = (bf16*)(ws + WS_WOUT);
    float* x1f = (float*)(ws + WS_X1F); bf16* big = (bf16*)(ws + WS_BIG); float* dtbuf = (float*)(ws + WS_DT); float* dec = (float*)(ws + WS_DEC);
    bf16* xb = (bf16*)(dob + DO_XB); bf16* states = (bf16*)(dob + DO_ST);
    LAS float* scr = (LAS float*)(lds + wave * 16384);

    ffn_weight_items(a.in[1], a.in[2], a.in[3], Wgu, Wd, scr, gw, NGW, lane);
    for (int it = gw; it < 16 * 273; it += NGW) { const int kb = it / 273, nb = it % 273, n0 = nb * 32; tr_item(a.in[6], 8736, kb * 64, n0, Win, 1024, map_in(n0), kb * 64, scr, lane); }
    for (int it = gw; it < 512 + 1024 + 512; it += NGW) { int r = it;
        if (r < 512) { tr_item(a.in[14], 1024, (r >> 5) * 64, (r & 31) * 32, Wcat, 1024, (r & 31) * 32, (r >> 5) * 64, scr, lane); continue; } r -= 512;
        if (r < 1024) { tr_item(a.in[15], 1024, (r >> 5) * 64, (r & 31) * 32, Wcat + (size_t)1024 * 1024, 2048, (r & 31) * 32, (r >> 5) * 64, scr, lane); continue; } r -= 1024;
        tr_item(a.in[16], 1024, (r >> 5) * 64, (r & 31) * 32, Wout, 1024, (r & 31) * 32, (r >> 5) * 64, scr, lane); }
    for (int i = gtid; i < 224 * 1024 / 8; i += nthr) *((u32x4*)(Win + (size_t)8736 * 1024) + i) = (u32x4){0u, 0u, 0u, 0u};
    for (int i = gtid; i < M * 1024 / 8; i += nthr) { const f32x4 v0 = *((const f32x4*)x + 2 * (size_t)i), v1 = *((const f32x4*)x + 2 * (size_t)i + 1);
        u32x4 o; o.x = cvtpk(v0.x, v0.y); o.y = cvtpk(v0.z, v0.w); o.z = cvtpk(v1.x, v1.y); o.w = cvtpk(v1.z, v1.w); *((u32x4*)xb + i) = o; }
    grid.sync();
#ifndef SKIP_GEMM1
    { pg8::Gemm g{xb, Wgu, M, 2 * DFF, 1024, 1024}; pg8::StaticOrder S; S.init(M, 2 * DFF, G, bid); pg8::EpiSwiGLU E{0, big, DFF};
      pg8::gemm_phase<pg8::EpiSwiGLU, pg8::StaticOrder, true, true>(lds, g, S, E); }
#endif
    grid.sync();
#ifndef SKIP_GEMM2
    { pg8::Gemm g{big, Wd, M, 1024, DFF, DFF}; pg8::StaticOrder S; S.init(M, 1024, G, bid); pg8::EpiResid E{0, x, x1f, 1024, ALPHA, 0.5f};
      pg8::gemm_phase<pg8::EpiResid, pg8::StaticOrder, true, true>(lds, g, S, E); }
#endif
    grid.sync();
    ln_rows(x1f, x1f, xb, a.in[4], a.in[5], M, gw, NGW, lane);
    grid.sync();
#pragma unroll 1
    for (int b = 0; b < 2; ++b) {
#ifndef SKIP_GEMM3
        { pg8::Gemm g{xb + (size_t)b * MB * 1024, Win, MB, NPROJ, 1024, 1024}; pg8::StaticOrder S; S.init(MB, NPROJ, G, bid); pg8::EpiInProj E{0, big, LDP, dtbuf};
          pg8::gemm_phase<pg8::EpiInProj, pg8::StaticOrder, true, true>(lds, g, S, E); }
#endif
        grid.sync();
#ifndef SKIP_S1
        for (int u = bid; u < 256; u += G) s1_unit(lds, big, dtbuf, dec, states, u >> 2, u & 3, a.in[7], a.in[8], a.in[9], a.in[10], tid);
#endif
#ifndef SKIP_ATTN
        for (int u = bid; u < 1024; u += G) attn_unit(lds, big, u >> 4, u & 15, a.in[13][u & 15], tid);
#endif
        grid.sync();
        scan_phase(states, dec, gtid, nthr);
        grid.sync();
#ifndef SKIP_S3
        for (int u = bid; u < 256; u += G) s3_unit(lds, big, dtbuf, states, u >> 2, u & 3, a.in[7], a.in[8], a.in[9], a.in[10], a.in[11], a.in[12], tid);
#endif
        grid.sync();
#ifndef SKIP_G4
        { pg8::Gemm g{big + PC_Q, Wcat, MB, 1024, 1024, LDP}; pg8::StaticOrder S; S.init(MB, 1024, G, bid); pg8::EpiGate<0> E{0, big + PC_GA, LDP, PC_GS - PC_GA};
          pg8::gemm_phase<pg8::EpiGate<0>, pg8::StaticOrder, true, true>(lds, g, S, E); }
        { pg8::Gemm g{big + PC_Z, Wcat + (size_t)1024 * 1024, MB, 1024, 2048, LDP}; pg8::StaticOrder S; S.init(MB, 1024, G, bid); pg8::EpiGate<1> E{0, big + PC_GA, LDP, PC_GS - PC_GA};
          pg8::gemm_phase<pg8::EpiGate<1>, pg8::StaticOrder, true, true>(lds, g, S, E); }
#endif
        grid.sync();
#ifndef SKIP_GEMM4
        { float* xr = x1f + (size_t)b * MB * 1024; pg8::Gemm g{big + PC_GA, Wout, MB, 1024, 1024, LDP}; pg8::StaticOrder S; S.init(MB, 1024, G, bid); pg8::EpiResid E{0, xr, xr, 1024, ALPHA, 1.0f};
          pg8::gemm_phase<pg8::EpiResid, pg8::StaticOrder, true, true>(lds, g, S, E); }
#endif
        grid.sync();
    }
    ffn_weight_items(a.in[19], a.in[20], a.in[21], Wgu, Wd, scr, gw, NGW, lane);
    ln_rows(x1f, x1f, xb, a.in[17], a.in[18], M, gw, NGW, lane);
    grid.sync();
#ifndef SKIP_GEMM5
    { pg8::Gemm g{xb, Wgu, M, 2 * DFF, 1024, 1024}; pg8::StaticOrder S; S.init(M, 2 * DFF, G, bid); pg8::EpiSwiGLU E{0, big, DFF};
      pg8::gemm_phase<pg8::EpiSwiGLU, pg8::StaticOrder, true, true>(lds, g, S, E); }
#endif
    grid.sync();
#ifndef SKIP_GEMM6
    { pg8::Gemm g{big, Wd, M, 1024, DFF, DFF}; pg8::StaticOrder S; S.init(M, 1024, G, bid); pg8::EpiResid E{0, x1f, a.out, 1024, ALPHA, 0.5f};
      pg8::gemm_phase<pg8::EpiResid, pg8::StaticOrder, true, true>(lds, g, S, E); }
#endif
    grid.sync();
    ln_rows(a.out, a.out, nullptr, a.in[22], a.in[23], M, gw, NGW, lane);
}

extern "C" void kernel_launch(void* const* d_in, const int* in_sizes, int n_in, void* d_out, int out_size, void* d_ws, size_t ws_size, hipStream_t stream) {
    static int grid = 0;
    if (grid == 0) {
        if (n_in != 24 || out_size != M * 1024 || ws_size < WS_END) { fprintf(stderr, "kernel_launch: unexpected shapes (n_in %d out %d ws %zu)\n", n_in, out_size, ws_size); grid = -1; return; }
        int dev = 0, cus = 0, per_cu = 0;
        (void)hipGetDevice(&dev); (void)hipDeviceGetAttribute(&cus, hipDeviceAttributeMultiprocessorCount, dev);
        (void)hipFuncSetAttribute((const void*)mega_fwd, hipFuncAttributeMaxDynamicSharedMemorySize, LDS_BYTES);
        (void)hipOccupancyMaxActiveBlocksPerMultiprocessor(&per_cu, (const void*)mega_fwd, NTHR, LDS_BYTES);
        if (per_cu < 1) per_cu = 1;
        grid = cus * per_cu; if (grid > 256) grid = 256;
        (void)hipGetLastError();
    }
    if (grid < 0) return;
    Args a{};
    for (int i = 0; i < 24; ++i) a.in[i] = (const float*)d_in[i];
    a.out = (float*)d_out; a.ws = (unsigned char*)d_ws;
    void* args[] = {&a};
    hipError_t e = hipLaunchCooperativeKernel((const void*)mega_fwd, dim3(grid), dim3(NTHR), args, LDS_BYTES, stream);
    if (e != hipSuccess) fprintf(stderr, "cooperative launch failed: %s (grid %d)\n", hipGetErrorString(e), grid);
}
```

```cpp
#include <hip/hip_runtime.h>
#include <hip/hip_cooperative_groups.h>
#include <cstdio>
#include <cstdint>
namespace cg = cooperative_groups;
namespace pg8 {
#define PG8_LAS __attribute__((address_space(3)))
typedef unsigned short bf16_t;
typedef short bf16x8 __attribute__((ext_vector_type(8)));
typedef float f32x4 __attribute__((ext_vector_type(4)));
typedef unsigned u32x4 __attribute__((ext_vector_type(4)));
constexpr int BM = 256, BK = 64, HALF = 128, HTB = HALF * BK * 2  , STAGE_BYTES = 8 * HTB, NXCD = 8, WGM = 8;

__host__ __device__ __forceinline__ int lds_byte(int r, int c) { const int st = (r >> 4) * 2 + (c >> 5), rr = r & 15, cc = c & 31, ob = rr * 64 + cc * 2; return st * 1024 + (ob ^ (((ob >> 9) & 1) << 5)); }
__host__ __device__ __forceinline__ void stage_rc(int b, int& R, int& C) { const int st = b / 1024, sb = b % 1024, swz = sb ^ (((sb >> 9) & 1) << 5); R = (st >> 1) * 16 + swz / 64; C = (st & 1) * 32 + (swz % 64) / 2; }
__host__ __device__ __forceinline__ int perm32(int rho) { const int n = rho >> 4, i = rho & 15; return 8 * (i >> 2) + 4 * n + (i & 3); }

struct Unit { int pm, pn; };
struct Gemm { const bf16_t* A; const bf16_t* Bt; int M, N, K, lda; };

struct StaticOrder {
    int nM, nN, nwg, G, c;
    __host__ __device__ void init(int M, int N, int G_, int c_) { nM = M / BM; nN = N / BM; nwg = nM * nN; G = G_; c = c_; }
    __host__ __device__ bool next(int i, Unit& u) const {
        const long L = (long)i * G + c; if (L >= nwg) return false;
        int wgid = (int)L; { const int q = nwg / NXCD, r = nwg % NXCD, xcd = wgid % NXCD, off = wgid / NXCD; wgid = (xcd < r ? xcd * (q + 1) : r * (q + 1) + (xcd - r) * q) + off; }
        const int nig = WGM * nN, gid = wgid / nig, fm = gid * WGM, gsz = (nM - fm) < WGM ? (nM - fm) : WGM;
        u.pm = fm + ((wgid % nig) % gsz); u.pn = (wgid % nig) / gsz; return true;
    }
    __device__ __forceinline__ void a_ready(const Unit&) const {}
    __device__ __forceinline__ void done(const Unit&) const {}
};

typedef float f32x2_t __attribute__((ext_vector_type(2))); typedef __bf16 bf16x2_t __attribute__((ext_vector_type(2)));
__device__ __forceinline__ unsigned cvtpk(float lo, float hi) { f32x2_t v = {lo, hi}; bf16x2_t b = __builtin_convertvector(v, bf16x2_t); return __builtin_bit_cast(unsigned, b); }
__device__ __forceinline__ float bflo(unsigned w) { return __uint_as_float(w << 16); }
__device__ __forceinline__ float bfhi(unsigned w) { return __uint_as_float(w & 0xffff0000u); }
__device__ __forceinline__ float sigmoidf_(float x) { return __builtin_amdgcn_rcpf(1.0f + __builtin_amdgcn_exp2f(-1.4426950408889634f * x)); }
__device__ __forceinline__ float siluf_(float x) { return x * sigmoidf_(x); }

struct EpiSwiGLU {
    static constexpr bool PERM = true, AFTER_DRAIN = false, HAS_MID = false; int mid_t;
    bf16_t* O; int ldc;
    __device__ __forceinline__ void mid(f32x4 (&)[2][2][4][2], const Unit&, int, int, int, int) const {}
    __device__ __forceinline__ void operator()(const f32x4 (&acc)[2][2][4][2], const Unit& u, int wr, int wc, int fr, int fq) const {
        const int row0 = u.pm * BM + wr * 64 + fr, col0 = u.pn * HALF + wc * 32 + 8 * fq;
#pragma unroll
        for (int ai = 0; ai < 2; ++ai)
#pragma unroll
            for (int m = 0; m < 4; ++m) { bf16_t* rowp = O + (size_t)(row0 + ai * HALF + m * 16) * ldc + col0;
                const f32x4 g0 = acc[ai][0][m][0], g1 = acc[ai][0][m][1], u0 = acc[ai][1][m][0], u1 = acc[ai][1][m][1];
                u32x4 w; w.x = cvtpk(siluf_(g0[0]) * u0[0], siluf_(g0[1]) * u0[1]); w.y = cvtpk(siluf_(g0[2]) * u0[2], siluf_(g0[3]) * u0[3]);
                w.z = cvtpk(siluf_(g1[0]) * u1[0], siluf_(g1[1]) * u1[1]); w.w = cvtpk(siluf_(g1[2]) * u1[2], siluf_(g1[3]) * u1[3]);
                *(u32x4*)rowp = w; }
    }
};
struct EpiResid {
    static constexpr bool PERM = false, AFTER_DRAIN = false, HAS_MID = false; int mid_t;
    const float* res; float* out; int ldc; float alpha, s;
    __device__ __forceinline__ void mid(f32x4 (&)[2][2][4][2], const Unit&, int, int, int, int) const {}
    __device__ __forceinline__ void operator()(const f32x4 (&acc)[2][2][4][2], const Unit& u, int wr, int wc, int fr, int fq) const {
        const int row0 = u.pm * BM + wr * 64 + fr, col0 = u.pn * BM + wc * 32 + 4 * fq;
#pragma unroll
        for (int ai = 0; ai < 2; ++ai)
#pragma unroll
            for (int m = 0; m < 4; ++m) { const size_t off = (size_t)(row0 + ai * HALF + m * 16) * ldc + col0;
#pragma unroll
                for (int bj = 0; bj < 2; ++bj)
#pragma unroll
                    for (int n = 0; n < 2; ++n) { const f32x4 r = *(const f32x4*)(res + off + bj * HALF + n * 16); *(f32x4*)(out + off + bj * HALF + n * 16) = r * alpha + acc[ai][bj][m][n] * s; } }
    }
};
struct EpiInProj {
    static constexpr bool PERM = true, AFTER_DRAIN = false, HAS_MID = false; int mid_t;
    bf16_t* O; int ldc; float* dt;
    __device__ __forceinline__ void mid(f32x4 (&)[2][2][4][2], const Unit&, int, int, int, int) const {}
    __device__ __forceinline__ void operator()(const f32x4 (&acc)[2][2][4][2], const Unit& u, int wr, int wc, int fr, int fq) const {
        const int row0 = u.pm * BM + wr * 64 + fr;
        if (u.pn == 34) {
            if (wc == 0) {
#pragma unroll
                for (int ai = 0; ai < 2; ++ai)
#pragma unroll
                    for (int m = 0; m < 4; ++m) { float* p = dt + (size_t)(row0 + ai * HALF + m * 16) * 32 + 8 * fq; *(f32x4*)p = acc[ai][0][m][0]; *(f32x4*)(p + 4) = acc[ai][0][m][1]; }
            }
            return;
        }
        const bool gate = u.pn >= 26; const int col0 = u.pn * BM + wc * 32 + 8 * fq;
#pragma unroll
        for (int ai = 0; ai < 2; ++ai)
#pragma unroll
            for (int m = 0; m < 4; ++m) { bf16_t* rowp = O + (size_t)(row0 + ai * HALF + m * 16) * ldc + col0;
#pragma unroll
                for (int bj = 0; bj < 2; ++bj) { f32x4 v0 = acc[ai][bj][m][0], v1 = acc[ai][bj][m][1];
                    if (gate) {
#pragma unroll
                        for (int i = 0; i < 4; ++i) { v0[i] = sigmoidf_(v0[i]); v1[i] = sigmoidf_(v1[i]); } }
                    u32x4 w; w.x = cvtpk(v0[0], v0[1]); w.y = cvtpk(v0[2], v0[3]); w.z = cvtpk(v1[0], v1[1]); w.w = cvtpk(v1[2], v1[3]);
                    *(u32x4*)(rowp + bj * HALF) = w; } }
    }
};
template <int MODE> struct EpiGate {
    static constexpr bool PERM = true, AFTER_DRAIN = false, HAS_MID = false; int mid_t;
    bf16_t* G; int ldc; int gsoff;
    __device__ __forceinline__ void mid(f32x4 (&)[2][2][4][2], const Unit&, int, int, int, int) const {}
    __device__ __forceinline__ void operator()(const f32x4 (&acc)[2][2][4][2], const Unit& u, int wr, int wc, int fr, int fq) const {
        const int row0 = u.pm * BM + wr * 64 + fr, col0 = u.pn * BM + wc * 32 + 8 * fq;
#pragma unroll
        for (int ai = 0; ai < 2; ++ai)
#pragma unroll
            for (int m = 0; m < 4; ++m) { bf16_t* rowp = G + (size_t)(row0 + ai * HALF + m * 16) * ldc + col0;
#pragma unroll
                for (int bj = 0; bj < 2; ++bj) { const u32x4 t = *(const u32x4*)(rowp + bj * HALF); const f32x4 v0 = acc[ai][bj][m][0], v1 = acc[ai][bj][m][1]; u32x4 w;
                    if (MODE == 0) { w.x = cvtpk(v0[0] * bflo(t.x), v0[1] * bfhi(t.x)); w.y = cvtpk(v0[2] * bflo(t.y), v0[3] * bfhi(t.y));
                        w.z = cvtpk(v1[0] * bflo(t.z), v1[1] * bfhi(t.z)); w.w = cvtpk(v1[2] * bflo(t.w), v1[3] * bfhi(t.w)); }
                    else { const u32x4 s = *(const u32x4*)(rowp + bj * HALF + gsoff);
                        w.x = cvtpk(bflo(t.x) + v0[0] * bflo(s.x), bfhi(t.x) + v0[1] * bfhi(s.x)); w.y = cvtpk(bflo(t.y) + v0[2] * bflo(s.y), bfhi(t.y) + v0[3] * bfhi(s.y));
                        w.z = cvtpk(bflo(t.z) + v1[0] * bflo(s.z), bfhi(t.z) + v1[1] * bfhi(s.z)); w.w = cvtpk(bflo(t.w) + v1[2] * bflo(s.w), bfhi(t.w) + v1[3] * bfhi(s.w)); }
                    *(u32x4*)(rowp + bj * HALF) = w; } }
    }
};
template <class Epi, class Sched, bool ALIGN_EPI = false, bool SP2 = false>
__device__ __forceinline__ void gemm_phase(PG8_LAS unsigned char* lds, const Gemm g, const Sched& S, const Epi& E) {
    int tid_ = threadIdx.x; asm volatile("" : "+v"(tid_)); const int tid = tid_, wid = __builtin_amdgcn_readfirstlane(tid >> 6), lane = tid & 63, wr = wid >> 2, wc = wid & 3, fr = lane & 15, fq = lane >> 4;
    const int K = g.K, nt = K / BK;
    unsigned voffA[2], voffB[2];
#pragma unroll
    for (int i = 0; i < 2; ++i) { int R, C; stage_rc(tid * 16 + i * 8192, R, C); const int Rb = Epi::PERM ? ((R & ~31) + perm32(R & 31)) : R;
        voffA[i] = (unsigned)(R * g.lda + C) * 2u; voffB[i] = (unsigned)(Rb * K + C) * 2u; }
    const size_t kstep = (size_t)(BK * 2);
    const size_t hstepB = (size_t)HALF * K * 2, hstepA = (size_t)HALF * g.lda * 2;
    const size_t tstepA = 2 * hstepA, tstepB = 2 * hstepB;
    const unsigned ldsw = (unsigned)wid * 1024u;
    const int aoff = lds_byte(wr * 64 + fr, fq * 8), boff = lds_byte(wc * 32 + fr, fq * 8);
#define PG8_SA(b, h) (((b) * 2 + (h)) * HTB)
#define PG8_SB(b, h) ((4 + (b) * 2 + (h)) * HTB)
#define PG8_STAGE(bufoff, gbase, voff) do { _Pragma("unroll") for (int _i = 0; _i < 2; ++_i) \
        __builtin_amdgcn_global_load_lds((const unsigned*)((const char*)(gbase) + (voff)[_i]), (PG8_LAS unsigned*)(lds + (bufoff) + ldsw + _i * 8192), 16, 0, 0); } while (0)
#define PG8_LDA(dst, b, h) do { _Pragma("unroll") for (int m = 0; m < 4; ++m) _Pragma("unroll") for (int k = 0; k < 2; ++k) dst[m][k] = *(const PG8_LAS bf16x8*)(lds + PG8_SA(b, h) + aoff + m * 2048 + k * 1024); } while (0)
#define PG8_LDB(dst, b, h) do { _Pragma("unroll") for (int n = 0; n < 2; ++n) _Pragma("unroll") for (int k = 0; k < 2; ++k) dst[n][k] = *(const PG8_LAS bf16x8*)(lds + PG8_SB(b, h) + boff + n * 2048 + k * 1024); } while (0)
#define PG8_MMA(ai, bj, At, Bt) do { __builtin_amdgcn_s_setprio(1); _Pragma("unroll") for (int m = 0; m < 4; ++m) _Pragma("unroll") for (int n = 0; n < 2; ++n) _Pragma("unroll") for (int k = 0; k < 2; ++k) \
        acc[ai][bj][m][n] = __builtin_amdgcn_mfma_f32_16x16x32_bf16(Bt[n][k], At[m][k], acc[ai][bj][m][n], 0, 0, 0); __builtin_amdgcn_s_setprio(0); } while (0)
#define PG8_WAIT_V(n) asm volatile("s_waitcnt vmcnt(" #n ")" ::: "memory")
#define PG8_WAIT_L(n) asm volatile("s_waitcnt lgkmcnt(" #n ")" ::: "memory")
#define PG8_BAR __builtin_amdgcn_s_barrier()
#define PG8_SCHED __builtin_amdgcn_sched_barrier(0)
    Unit cur, nxt; int ui = 0;
    if (!S.next(0, cur)) return;
    f32x4 acc[2][2][4][2];
#pragma unroll
    for (int a = 0; a < 2; ++a)
#pragma unroll
        for (int b = 0; b < 2; ++b)
#pragma unroll
            for (int m = 0; m < 4; ++m)
#pragma unroll
                for (int n = 0; n < 2; ++n) acc[a][b][m][n] = (f32x4){0.f, 0.f, 0.f, 0.f};
    bf16x8 At[4][2], B0[2][2], B1[2][2];
    const char* cA = (const char*)g.A + (size_t)cur.pm * tstepA; const char* cB = (const char*)g.Bt + (size_t)cur.pn * tstepB;
    S.a_ready(cur);
    if constexpr (SP2) {
        PG8_STAGE(PG8_SB(0, 0), cB, voffB); PG8_STAGE(PG8_SB(0, 1), cB + hstepB, voffB); PG8_STAGE(PG8_SA(0, 0), cA, voffA); PG8_STAGE(PG8_SA(0, 1), cA + hstepA, voffA);
        if (wr == 1) PG8_BAR;
        PG8_WAIT_V(2); PG8_BAR;
        PG8_STAGE(PG8_SB(1, 0), cB + kstep, voffB); PG8_STAGE(PG8_SA(1, 0), cA + kstep, voffA); PG8_STAGE(PG8_SB(1, 1), cB + hstepB + kstep, voffB);
        PG8_WAIT_V(6); PG8_BAR;
    } else {
        PG8_STAGE(PG8_SB(0, 0), cB, voffB); PG8_STAGE(PG8_SA(0, 0), cA, voffA); PG8_STAGE(PG8_SB(0, 1), cB + hstepB, voffB); PG8_STAGE(PG8_SA(0, 1), cA + hstepA, voffA);
        if (wr == 1) PG8_BAR;
        PG8_WAIT_V(4); PG8_BAR;
        PG8_STAGE(PG8_SB(1, 0), cB + kstep, voffB); PG8_STAGE(PG8_SA(1, 0), cA + kstep, voffA); PG8_STAGE(PG8_SB(1, 1), cB + hstepB + kstep, voffB);
        PG8_WAIT_V(6); PG8_BAR;
    }
    for (;;) {
        const bool has_next = S.next(ui + 1, nxt);
        const char* nA = has_next ? (const char*)g.A + (size_t)nxt.pm * tstepA : cA; const char* nB = has_next ? (const char*)g.Bt + (size_t)nxt.pn * tstepB : cB;
        for (int t = 0; t < nt; t += 2) {
            if constexpr (Epi::HAS_MID) { if (t == E.mid_t) E.mid(acc, cur, wr, wc, fr, fq); }
            const bool last = (t == nt - 2);
            const char* a1 = cA + (size_t)(t + 1) * kstep;
            const char* a2 = last ? nA : cA + (size_t)(t + 2) * kstep; const char* b2 = last ? nB : cB + (size_t)(t + 2) * kstep;
            const char* a3 = a2 + kstep; const char* b3 = b2 + kstep;
            if (last && has_next) S.a_ready(nxt);
            if constexpr (SP2) {
            PG8_LDB(B0, 0, 0); PG8_LDB(B1, 0, 1); PG8_SCHED; PG8_LDA(At, 0, 0); PG8_STAGE(PG8_SA(1, 1), a1 + hstepA, voffA);
            PG8_WAIT_V(8); PG8_WAIT_L(0); PG8_BAR; PG8_MMA(0, 0, At, B0); PG8_MMA(0, 1, At, B1); PG8_BAR; PG8_SCHED;
            PG8_LDA(At, 0, 1); PG8_STAGE(PG8_SB(0, 0), b2, voffB); PG8_STAGE(PG8_SB(0, 1), b2 + hstepB, voffB); PG8_STAGE(PG8_SA(0, 0), a2, voffA);
            PG8_WAIT_V(8); PG8_WAIT_L(0); PG8_BAR; PG8_MMA(1, 0, At, B0); PG8_MMA(1, 1, At, B1); PG8_BAR; PG8_SCHED;
            PG8_LDB(B0, 1, 0); PG8_LDB(B1, 1, 1); PG8_SCHED; PG8_LDA(At, 1, 0); PG8_STAGE(PG8_SA(0, 1), a2 + hstepA, voffA);
            PG8_WAIT_V(8); PG8_WAIT_L(0); PG8_BAR; PG8_MMA(0, 0, At, B0); PG8_MMA(0, 1, At, B1); PG8_BAR; PG8_SCHED;
            PG8_LDA(At, 1, 1); PG8_STAGE(PG8_SB(1, 0), b3, voffB); PG8_STAGE(PG8_SB(1, 1), b3 + hstepB, voffB); PG8_STAGE(PG8_SA(1, 0), a3, voffA);
            PG8_WAIT_V(8); PG8_WAIT_L(0); PG8_BAR; PG8_MMA(1, 0, At, B0); PG8_MMA(1, 1, At, B1); PG8_BAR; PG8_SCHED;
            } else {
            PG8_LDB(B0, 0, 0); PG8_SCHED; PG8_LDA(At, 0, 0); PG8_STAGE(PG8_SA(1, 1), a1 + hstepA, voffA);
            PG8_WAIT_L(8); PG8_BAR; PG8_WAIT_L(0); PG8_MMA(0, 0, At, B0); PG8_BAR; PG8_SCHED;
            PG8_LDB(B1, 0, 1); PG8_STAGE(PG8_SB(0, 0), b2, voffB);
            PG8_BAR; PG8_WAIT_L(0); PG8_MMA(0, 1, At, B1); PG8_BAR;
            PG8_LDA(At, 0, 1); PG8_STAGE(PG8_SA(0, 0), a2, voffA);
            PG8_BAR; PG8_WAIT_L(0); PG8_MMA(1, 0, At, B0); PG8_BAR; PG8_SCHED;
            PG8_STAGE(PG8_SB(0, 1), b2 + hstepB, voffB);
            PG8_WAIT_V(6); PG8_BAR; PG8_MMA(1, 1, At, B1); PG8_BAR;
            PG8_LDB(B0, 1, 0); PG8_SCHED; PG8_LDA(At, 1, 0); PG8_STAGE(PG8_SA(0, 1), a2 + hstepA, voffA);
            PG8_WAIT_L(8); PG8_BAR; PG8_WAIT_L(0); PG8_MMA(0, 0, At, B0); PG8_BAR; PG8_SCHED;
            PG8_LDB(B1, 1, 1); PG8_STAGE(PG8_SB(1, 0), b3, voffB);
            PG8_BAR; PG8_WAIT_L(0); PG8_MMA(0, 1, At, B1); PG8_BAR;
            PG8_LDA(At, 1, 1); PG8_STAGE(PG8_SA(1, 0), a3, voffA);
            PG8_BAR; PG8_WAIT_L(0); PG8_MMA(1, 0, At, B0); PG8_BAR; PG8_SCHED;
            PG8_STAGE(PG8_SB(1, 1), b3 + hstepB, voffB);
            PG8_WAIT_V(6); PG8_BAR; PG8_MMA(1, 1, At, B1); PG8_BAR;
            }
        }
        if constexpr (ALIGN_EPI) { if (wr == 0) PG8_BAR; }
        if constexpr (!Epi::AFTER_DRAIN) { E(acc, cur, wr, wc, fr, fq); S.done(cur); }
        if (!has_next) break;
#pragma unroll
        for (int a = 0; a < 2; ++a)
#pragma unroll
            for (int b = 0; b < 2; ++b)
#pragma unroll
                for (int m = 0; m < 4; ++m)
#pragma unroll
                    for (int n = 0; n < 2; ++n) acc[a][b][m][n] = (f32x4){0.f, 0.f, 0.f, 0.f};
        cur = nxt; cA = nA; cB = nB; ++ui;
        if constexpr (ALIGN_EPI) { if (wr == 1) PG8_BAR; }
    }
    PG8_WAIT_V(0);
    if constexpr (!ALIGN_EPI) { if (wr == 0) PG8_BAR; }
    PG8_BAR;
    if constexpr (Epi::AFTER_DRAIN) { E.fused(acc, cur, wr, wc, fr, fq, lds, wid, lane); S.done(cur); }
#undef PG8_SA
#undef PG8_SB
#undef PG8_STAGE
#undef PG8_LDA
#undef PG8_LDB
#undef PG8_MMA
#undef PG8_WAIT_V
#undef PG8_WAIT_L
#undef PG8_BAR
#undef PG8_SCHED
}
}

#define LAS __attribute__((address_space(3)))
typedef unsigned short bf16;
typedef float f32x4 __attribute__((ext_vector_type(4)));
typedef short bf16x8 __attribute__((ext_vector_type(8)));
typedef short bf16x4 __attribute__((ext_vector_type(4)));
typedef unsigned u32x4 __attribute__((ext_vector_type(4)));
typedef unsigned u32x2 __attribute__((ext_vector_type(2)));
using pg8::cvtpk; using pg8::bflo; using pg8::bfhi; using pg8::siluf_; using pg8::sigmoidf_;
constexpr int NWAVES = 8, NTHR = 512;
constexpr int M = 16384, MB = 8192, DMODEL = 1024, DFF = 2816;
constexpr int LDP = 8704;
constexpr int PC_Q = 0, PC_Z = 1024, PC_K = 3072, PC_V = 3328, PC_XBC = 3584, PC_GA = 6656, PC_GS = 7680;
constexpr int NPROJ = 8960;
constexpr float LN_EPS = 1e-5f, RMS_EPS = 1e-5f;
constexpr float ALPHA = 1.189207115002721f;
constexpr size_t MiB = 1u << 20;
constexpr size_t WS_CTL = 0, WS_DEC = 512 * 1024, WS_DT = 1 * MiB, WS_WGU = 2 * MiB, WS_WD = 13 * MiB, WS_WIN = 19 * MiB, WS_WCAT = 37 * MiB, WS_WOUT = 43 * MiB, WS_X1F = 45 * MiB, WS_BIG = 109 * MiB, WS_END = 245 * MiB;
constexpr size_t DO_XB = 0, DO_ST = 32 * MiB;
constexpr int LDS_BYTES = 147456;

#define LDS_WAIT() asm volatile("s_waitcnt lgkmcnt(0)" ::: "memory")
#define MFMA16(a, b, c) __builtin_amdgcn_mfma_f32_16x16x32_bf16((a), (b), (c), 0, 0, 0)

__device__ __forceinline__ float wave_sum(float v) {
#pragma unroll
    for (int o = 1; o < 64; o <<= 1) v += __shfl_xor(v, o);
    return v;
}
__device__ __forceinline__ void tr_item(const float* W, int ldw, int k0, int n0, bf16* WT, int ldt, int drow, int dcol, LAS float* scr, int lane) {
#pragma unroll 8
    for (int i = 0; i < 32; ++i) { const int kk = 2 * i + (lane >> 5); scr[kk * 33 + (lane & 31)] = W[(size_t)(k0 + kk) * ldw + n0 + (lane & 31)]; }
    LDS_WAIT(); asm volatile("" ::: "memory");
    const int c = lane & 7;
#pragma unroll
    for (int j = 0; j < 4; ++j) { const int n = (lane >> 3) + 8 * j; const LAS float* s = scr + (8 * c) * 33 + n;
        u32x4 o; o.x = cvtpk(s[0 * 33], s[1 * 33]); o.y = cvtpk(s[2 * 33], s[3 * 33]); o.z = cvtpk(s[4 * 33], s[5 * 33]); o.w = cvtpk(s[6 * 33], s[7 * 33]);
        *(u32x4*)(WT + (size_t)(drow + n) * ldt + dcol + 8 * c) = o; }
    LDS_WAIT(); asm volatile("" ::: "memory");
}
__device__ __forceinline__ int map_in(int n0) {
    if (n0 < 1024) return n0;
    if (n0 < 1280) return PC_K + (n0 - 1024);
    if (n0 < 1536) return PC_V + (n0 - 1280);
    if (n0 < 3584) return PC_Z + (n0 - 1536);
    if (n0 < 6656) return n0;
    if (n0 < 6688) return 8704 + (n0 - 6656);
    if (n0 < 7712) return PC_GA + (n0 - 6688);
    return PC_GS + (n0 - 7712);
}
__device__ __forceinline__ void ffn_weight_items(const float* wg, const float* wu, const float* wd, bf16* Wgu, bf16* Wd, LAS float* scr, int gw, int NGW, int lane) {
    constexpr int I_G = 16 * 88, I_D = 44 * 32;
    for (int it = gw; it < 2 * I_G + I_D; it += NGW) {
        int r = it;
        if (r < 2 * I_G) { const bool up = r >= I_G; if (up) r -= I_G; const int kb = r / 88, nb = r % 88, n0 = nb * 32;
            tr_item(up ? wu : wg, DFF, kb * 64, n0, Wgu, 1024, (n0 >> 7) * 256 + (n0 & 127) + (up ? 128 : 0), kb * 64, scr, lane); continue; }
        r -= 2 * I_G; { const int kb = r / 32, nb = r % 32; tr_item(wd, 1024, kb * 64, nb * 32, Wd, DFF, nb * 32, kb * 64, scr, lane); }
    }
}
__device__ __forceinline__ void ln_rows(const float* src, float* dstf, bf16* dstb, const float* g, const float* b, int nrows, int gw, int NGW, int lane) {
    f32x4 gv[4], bv[4];
#pragma unroll
    for (int j = 0; j < 4; ++j) { gv[j] = *((const f32x4*)g + lane + 64 * j); bv[j] = *((const f32x4*)b + lane + 64 * j); }
    for (int m = gw; m < nrows; m += NGW) {
        const f32x4* xr = (const f32x4*)(src + (size_t)m * 1024) + lane;
        f32x4 v[4]; float s = 0.f;
#pragma unroll
        for (int j = 0; j < 4; ++j) { v[j] = xr[64 * j]; s += (v[j].x + v[j].y) + (v[j].z + v[j].w); }
        const float mean = wave_sum(s) * (1.f / 1024.f); float s2 = 0.f;
#pragma unroll
        for (int j = 0; j < 4; ++j) { v[j] = v[j] - mean; s2 += (v[j].x * v[j].x + v[j].y * v[j].y) + (v[j].z * v[j].z + v[j].w * v[j].w); }
        const float rstd = 1.f / sqrtf(wave_sum(s2) * (1.f / 1024.f) + LN_EPS);
#pragma unroll
        for (int j = 0; j < 4; ++j) { const f32x4 y = v[j] * rstd * gv[j] + bv[j];
            if (dstf) *((f32x4*)(dstf + (size_t)m * 1024) + lane + 64 * j) = y;
            if (dstb) { u32x2 w; w.x = cvtpk(y.x, y.y); w.y = cvtpk(y.z, y.w); *((u32x2*)(dstb + (size_t)m * 1024) + lane + 64 * j) = w; } }
    }
}
struct ConvW { f32x4 w[4][2]; f32x4 b[2]; };
__device__ __forceinline__ void conv_load_w(ConvW& cw, const float* conv_w, const float* conv_b, int xch) {
#pragma unroll
    for (int j = 0; j < 4; ++j) { cw.w[j][0] = *(const f32x4*)(conv_w + j * 3072 + xch); cw.w[j][1] = *(const f32x4*)(conv_w + j * 3072 + xch + 4); }
    cw.b[0] = *(const f32x4*)(conv_b + xch); cw.b[1] = *(const f32x4*)(conv_b + xch + 4);
}
__device__ __forceinline__ void conv8(const bf16* P, int row, int xch, const ConvW& cw, float (&o)[8]) {
    f32x4 a0 = cw.b[0], a1 = cw.b[1];
#pragma unroll
    for (int j = 0; j < 4; ++j) { const int r = row - 3 + j;
        if (r >= 0) { const u32x4 v = *(const u32x4*)(P + (size_t)r * LDP + PC_XBC + xch);
            a0[0] += cw.w[j][0][0] * bflo(v.x); a0[1] += cw.w[j][0][1] * bfhi(v.x); a0[2] += cw.w[j][0][2] * bflo(v.y); a0[3] += cw.w[j][0][3] * bfhi(v.y);
            a1[0] += cw.w[j][1][0] * bflo(v.z); a1[1] += cw.w[j][1][1] * bfhi(v.z); a1[2] += cw.w[j][1][2] * bflo(v.w); a1[3] += cw.w[j][1][3] * bfhi(v.w); } }
#pragma unroll
    for (int i = 0; i < 4; ++i) { o[i] = siluf_(a0[i]); o[4 + i] = siluf_(a1[i]); }
}
__device__ __forceinline__ void chunk_decay(const float* dtbuf, int row0, int head, float bias, float Aneg, int lane, float& dt0, float& dt1, float& ac0, float& ac1) {
    float r0 = dtbuf[(size_t)(row0 + 2 * lane) * 32 + head] + bias, r1 = dtbuf[(size_t)(row0 + 2 * lane + 1) * 32 + head] + bias;
    dt0 = fmaxf(r0, 0.f) + log1pf(__expf(-fabsf(r0))); dt1 = fmaxf(r1, 0.f) + log1pf(__expf(-fabsf(r1)));
    const float a0 = dt0 * Aneg, a1 = dt1 * Aneg;
    float s = a0 + a1;
#pragma unroll
    for (int o = 1; o < 64; o <<= 1) { const float t = __shfl_up(s, o); if (lane >= o) s += t; }
    ac1 = s; ac0 = s - a1;
}

#define XB_TMO      128
#define XB_XCNT(j)  (256  + 64 * (j))
#define XB_XSUB(j)  (1280 + 64 * (j))
#define XB_XGEN(j)  (2304 + 64 * (j))
#define XB_TOP      3328
#define XB_TOPGEN   3392
#define XCD_BAR_WORDS 3456
#define XB_SPIN_CAP (1u << 18)

__device__ __forceinline__ unsigned xb_ld(unsigned* p)              { return __hip_atomic_load(p, __ATOMIC_RELAXED, __HIP_MEMORY_SCOPE_AGENT); }
__device__ __forceinline__ unsigned xb_add(unsigned* p, unsigned v) { return __hip_atomic_fetch_add(p, v, __ATOMIC_RELAXED, __HIP_MEMORY_SCOPE_AGENT); }
__device__ __forceinline__ unsigned xb_xcc_id() { return (unsigned)__builtin_amdgcn_s_getreg((3 << 11) | 20) & 0xFu; }
#define XB_SPIN(cond, bar) do { unsigned _sp = 0; while (cond) { __builtin_amdgcn_s_sleep(1); \
    if ((++_sp & 255u) == 0u) { if (xb_ld(&(bar)[XB_TMO])) break; if (_sp > XB_SPIN_CAP) { atomicAdd(&(bar)[XB_TMO], 1u); break; } } } } while (0)

struct XcdBarrier {
    unsigned* bar; unsigned x;
    volatile LAS unsigned* st;
};

__device__ __forceinline__ XcdBarrier xcd_barrier_post(unsigned* bar, volatile LAS unsigned* st) {
    XcdBarrier b; b.bar = bar; b.x = xb_xcc_id(); b.st = st;
    if (threadIdx.x == 0) (void)xb_add(&bar[XB_XCNT(b.x)], 1u);
    return b;
}
__device__ __forceinline__ void xcd_barrier_complete(unsigned* bar, unsigned x, unsigned& nloc, unsigned& nx) {
    const unsigned G = gridDim.x * gridDim.y * gridDim.z;
    unsigned sum, cnt, mine, sp = 0u;
    for (;;) {
        sum = 0u; cnt = 0u; mine = 0u;
#pragma unroll
        for (unsigned j = 0; j < 16; ++j) { const unsigned c = xb_ld(&bar[XB_XCNT(j)]); sum += c; cnt += (c > 0u) ? 1u : 0u; mine = (j == x) ? c : mine; }
        if (sum == G) break;
        __builtin_amdgcn_s_sleep(1);
        if ((++sp & 255u) == 0u) { if (xb_ld(&bar[XB_TMO])) break; if (sp > XB_SPIN_CAP) { atomicAdd(&bar[XB_TMO], 1u); break; } }
    }
    nloc = mine > 0u ? mine : 1u; nx = cnt > 0u ? cnt : 1u;
}

__device__ __forceinline__ void xcd_barrier(const XcdBarrier& b) {
    asm volatile("s_waitcnt vmcnt(0)" ::: "memory");
    __syncthreads();
    if (threadIdx.x == 0) {
        unsigned* bar = b.bar;
        __builtin_amdgcn_s_waitcnt(0);
        unsigned nloc = b.st[0], nx = b.st[1];
        if (nloc == 0u) { xcd_barrier_complete(bar, b.x, nloc, nx); b.st[0] = nloc; b.st[1] = nx; }
        const unsigned old = xb_add(&bar[XB_XSUB(b.x)], 1u);
        const unsigned gen = old / nloc;
        if (old + 1u == (gen + 1u) * nloc) {
            __builtin_amdgcn_fence(__ATOMIC_RELEASE, "agent");
            asm volatile("s_waitcnt vmcnt(0)" ::: "memory");
            const unsigned og = xb_add(&bar[XB_TOP], 1u);
            const unsigned tg = og / nx;
            if (og + 1u == (tg + 1u) * nx) xb_add(&bar[XB_TOPGEN], 1u);
            else XB_SPIN(xb_ld(&bar[XB_TOPGEN]) == tg, bar);
            __builtin_amdgcn_fence(__ATOMIC_ACQUIRE, "agent");
            xb_add(&bar[XB_XGEN(b.x)], 1u);
            asm volatile("s_waitcnt vmcnt(0)" ::: "memory");
        } else {
            XB_SPIN(xb_ld(&bar[XB_XGEN(b.x)]) == gen, bar);
            __builtin_amdgcn_fence(__ATOMIC_ACQUIRE, "agent");
            asm volatile("s_waitcnt vmcnt(0)" ::: "memory");
        }
    }
    __syncthreads();
}

constexpr int AT_QS = 0, AT_KS = 18432, AT_VT = 55296, AT_PS = 91136, AT_END = AT_PS + 8 * 16 * 336;
static_assert(AT_END <= 147456, "attention LDS");
__device__ __forceinline__ void attn_unit(LAS unsigned char* lds, bf16* P, int blk, int h, float sink, int tid_in) {
    int tid = tid_in; asm volatile("" : "+v"(tid));
    const int lane = tid & 63, w = __builtin_amdgcn_readfirstlane(tid >> 6), fr = lane & 15, kg = lane >> 4;
    const int row0 = blk * 128, g = h >> 2;
#pragma unroll
    for (int i = 0; i < 2; ++i) { const int idx = tid + 512 * i, r = idx >> 3, ch = idx & 7;
        const u32x4 v = *(const u32x4*)(P + (size_t)(row0 + r) * LDP + PC_Q + h * 64 + ch * 8); *(LAS u32x4*)(lds + AT_QS + r * 144 + ch * 16) = v; }
#pragma unroll
    for (int i = 0; i < 4; ++i) { const int idx = tid + 512 * i, kj = idx >> 3, ch = idx & 7; const int srow = (blk > 0) ? row0 - 128 + kj : row0 + (kj & 127);
        const u32x4 v = *(const u32x4*)(P + (size_t)srow * LDP + PC_K + g * 64 + ch * 8); *(LAS u32x4*)(lds + AT_KS + kj * 144 + ch * 16) = v; }
#pragma unroll
    for (int i = 0; i < 4; ++i) { const int idx = tid + 512 * i, kj = idx & 255, ch = idx >> 8; const int srow = (blk > 0) ? row0 - 128 + kj : row0 + (kj & 127);
        const u32x4 v = *(const u32x4*)(P + (size_t)srow * LDP + PC_V + g * 64 + ch * 8);
        LAS unsigned short* d = (LAS unsigned short*)(lds + AT_VT + (ch * 8) * 560 + kj * 2);
        d[0 * 280] = (unsigned short)(v.x & 0xffffu); d[1 * 280] = (unsigned short)(v.x >> 16); d[2 * 280] = (unsigned short)(v.y & 0xffffu); d[3 * 280] = (unsigned short)(v.y >> 16);
        d[4 * 280] = (unsigned short)(v.z & 0xffffu); d[5 * 280] = (unsigned short)(v.z >> 16); d[6 * 280] = (unsigned short)(v.w & 0xffffu); d[7 * 280] = (unsigned short)(v.w >> 16); }
    for (int idx = tid; idx < 64 * 12; idx += 512) { const int d = idx / 12, wv = idx % 12; *(LAS unsigned*)(lds + AT_VT + d * 560 + 512 + wv * 4) = 0u; }
    { const int row = lane >> 2, part = lane & 3; *(LAS u32x2*)(lds + AT_PS + w * 5376 + row * 336 + 288 + part * 8) = (u32x2){0u, 0u}; }
    __syncthreads();
    bf16x8 qf[2];
#pragma unroll
    for (int ks = 0; ks < 2; ++ks) qf[ks] = *(const LAS bf16x8*)(lds + AT_QS + (16 * w + fr) * 144 + (32 * ks + 8 * kg) * 2);
    f32x4 s[9];
#pragma unroll
    for (int ti = 0; ti < 9; ++ti) { const int t = w + ti; f32x4 acc = {0.f, 0.f, 0.f, 0.f};
#pragma unroll
        for (int ks = 0; ks < 2; ++ks) { const bf16x8 kf = *(const LAS bf16x8*)(lds + AT_KS + (16 * t + fr) * 144 + (32 * ks + 8 * kg) * 2); acc = MFMA16(kf, qf[ks], acc); }
        s[ti] = acc; }
    const int qi = 128 + 16 * w + fr; float mx = sink;
#pragma unroll
    for (int ti = 0; ti < 9; ++ti)
#pragma unroll
        for (int j = 0; j < 4; ++j) { const int kj = 16 * (w + ti) + 4 * kg + j, d = qi - kj; const bool valid = (d >= 0) && (d < 128) && (blk > 0 || kj >= 128);
            const float v = valid ? s[ti][j] * 0.125f : -INFINITY; s[ti][j] = v; mx = fmaxf(mx, v); }
    mx = fmaxf(mx, __shfl_xor(mx, 16)); mx = fmaxf(mx, __shfl_xor(mx, 32));
    float sum = 0.f;
#pragma unroll
    for (int ti = 0; ti < 9; ++ti) {
#pragma unroll
        for (int j = 0; j < 4; ++j) { const float p = __expf(s[ti][j] - mx); s[ti][j] = p; sum += p; }
        u32x2 pw; pw.x = cvtpk(s[ti][0], s[ti][1]); pw.y = cvtpk(s[ti][2], s[ti][3]);
        *(LAS u32x2*)(lds + AT_PS + w * 5376 + fr * 336 + (16 * ti + 4 * kg) * 2) = pw; }
    sum += __shfl_xor(sum, 16); sum += __shfl_xor(sum, 32);
    const float inv = 1.0f / (sum + __expf(sink - mx));
    LDS_WAIT(); asm volatile("" ::: "memory");
    f32x4 o[4];
#pragma unroll
    for (int dt = 0; dt < 4; ++dt) o[dt] = (f32x4){0.f, 0.f, 0.f, 0.f};
#pragma unroll
    for (int ks = 0; ks < 5; ++ks) { const bf16x8 pf = *(const LAS bf16x8*)(lds + AT_PS + w * 5376 + fr * 336 + (32 * ks + 8 * kg) * 2);
#pragma unroll
        for (int dt = 0; dt < 4; ++dt) { const bf16x8 vf = *(const LAS bf16x8*)(lds + AT_VT + (16 * dt + fr) * 560 + (16 * w + 32 * ks + 8 * kg) * 2); o[dt] = MFMA16(vf, pf, o[dt]); } }
    bf16* orow = P + (size_t)(row0 + 16 * w + fr) * LDP + PC_Q + h * 64 + 4 * kg;
#pragma unroll
    for (int dt = 0; dt < 4; ++dt) { u32x2 ow; ow.x = cvtpk(o[dt][0] * inv, o[dt][1] * inv); ow.y = cvtpk(o[dt][2] * inv, o[dt][3] * inv); *(u32x2*)(orow + 16 * dt) = ow; }
    __syncthreads();
}

constexpr int S1_BT = 0, S1_XW = 34816, S1_SW = 104448;
__device__ __forceinline__ void s1_unit(LAS unsigned char* lds, const bf16* P, const float* dtbuf, float* dec, bf16* states, int c, int g,
                                        const float* conv_w, const float* conv_b, const float* dt_bias, const float* a_log, int tid_in) {
    int tid = tid_in; asm volatile("" : "+v"(tid));
    const int lane = tid & 63, w = __builtin_amdgcn_readfirstlane(tid >> 6), fr = lane & 15, kg = lane >> 4;
    const int row0 = c * 128;
    { const int hh = 8 * g + w; const float Aneg = -__expf(a_log[hh]); float dt0, dt1, ac0, ac1;
      chunk_decay(dtbuf, row0, hh, dt_bias[hh], Aneg, lane, dt0, dt1, ac0, ac1);
      const float tot = __shfl(ac1, 63);
      LAS float* sw = (LAS float*)(lds + S1_SW) + w * 128;
      sw[2 * lane] = __expf(tot - ac0) * dt0; sw[2 * lane + 1] = __expf(tot - ac1) * dt1;
      if (lane == 63) dec[c * 32 + hh] = __expf(tot); }
    { const int ch = tid >> 5, xch = 2048 + g * 128 + ch * 8; ConvW cw; conv_load_w(cw, conv_w, conv_b, xch);
#pragma unroll 1
      for (int i = 0; i < 4; ++i) { const int l = (tid & 31) + 32 * i; float o[8]; conv8(P, row0 + l, xch, cw, o);
          LAS unsigned short* d = (LAS unsigned short*)(lds + S1_BT + (ch * 8) * 272 + l * 2);
#pragma unroll
          for (int e = 0; e < 8; e += 2) { const unsigned pw = cvtpk(o[e], o[e + 1]); d[e * 136] = (unsigned short)(pw & 0xffffu); d[(e + 1) * 136] = (unsigned short)(pw >> 16); } } }
#pragma unroll 1
    for (int half = 0; half < 2; ++half) {
        __syncthreads();
        { const int ch = tid >> 4, xch = g * 512 + half * 256 + ch * 8; const int hl = half * 4 + (ch >> 3); ConvW cw; conv_load_w(cw, conv_w, conv_b, xch);
          const LAS float* sw = (const LAS float*)(lds + S1_SW) + hl * 128;
#pragma unroll 1
          for (int i = 0; i < 8; ++i) { const int l = (tid & 15) + 16 * i; float o[8]; conv8(P, row0 + l, xch, cw, o); const float wv = sw[l];
              LAS unsigned short* d = (LAS unsigned short*)(lds + S1_XW + (ch * 8) * 272 + l * 2);
#pragma unroll
              for (int e = 0; e < 8; e += 2) { const unsigned pw = cvtpk(o[e] * wv, o[e + 1] * wv); d[e * 136] = (unsigned short)(pw & 0xffffu); d[(e + 1) * 136] = (unsigned short)(pw >> 16); } } }
        __syncthreads();
        const int hl = w >> 1, ph = w & 1;
        f32x4 acc[2][8];
#pragma unroll
        for (int pt = 0; pt < 2; ++pt)
#pragma unroll
            for (int nt = 0; nt < 8; ++nt) acc[pt][nt] = (f32x4){0.f, 0.f, 0.f, 0.f};
#pragma unroll
        for (int ks = 0; ks < 4; ++ks) { bf16x8 xf[2];
#pragma unroll
            for (int pt = 0; pt < 2; ++pt) xf[pt] = *(const LAS bf16x8*)(lds + S1_XW + (hl * 64 + ph * 32 + 16 * pt + fr) * 272 + (32 * ks + 8 * kg) * 2);
#pragma unroll
            for (int nt = 0; nt < 8; ++nt) { const bf16x8 bfr = *(const LAS bf16x8*)(lds + S1_BT + (16 * nt + fr) * 272 + (32 * ks + 8 * kg) * 2);
#pragma unroll
                for (int pt = 0; pt < 2; ++pt) acc[pt][nt] = MFMA16(bfr, xf[pt], acc[pt][nt]); } }
        const int hh = 8 * g + half * 4 + hl;
#pragma unroll
        for (int pt = 0; pt < 2; ++pt) { bf16* sp = states + ((size_t)(c * 32 + hh) * 64 + ph * 32 + 16 * pt + fr) * 128 + 4 * kg;
#pragma unroll
            for (int nt = 0; nt < 8; ++nt) { u32x2 ow; ow.x = cvtpk(acc[pt][nt][0], acc[pt][nt][1]); ow.y = cvtpk(acc[pt][nt][2], acc[pt][nt][3]); *(u32x2*)(sp + 16 * nt) = ow; } }
    }
    __syncthreads();
}
__device__ __forceinline__ void scan_phase(bf16* states, const float* dec, int gtid, int nthr) {
    for (int e = gtid; e < 131072; e += nthr) { const int head = e >> 12; unsigned* p = (unsigned*)states + (size_t)head * 4096 + (e & 4095);
        float h0 = 0.f, h1 = 0.f;
#pragma unroll 8
        for (int c = 0; c < 64; ++c) { const float d = dec[c * 32 + head]; const unsigned v = p[(size_t)c * 131072]; p[(size_t)c * 131072] = cvtpk(h0, h1); h0 = d * h0 + bflo(v); h1 = d * h1 + bfhi(v); } }
}
constexpr int S3_CS = 0, S3_R = 34816, S3_AC = 104448, S3_DT = 108544;
__device__ __forceinline__ void s3_unit(LAS unsigned char* lds, bf16* P, const float* dtbuf, const bf16* states, int c, int g,
                                        const float* conv_w, const float* conv_b, const float* dt_bias, const float* a_log, const float* d_skip, const float* norm_w, int tid_in) {
    int tid = tid_in; asm volatile("" : "+v"(tid));
    const int lane = tid & 63, w = __builtin_amdgcn_readfirstlane(tid >> 6), fr = lane & 15, kg = lane >> 4;
    const int row0 = c * 128;
    { const int hh = 8 * g + w; const float Aneg = -__expf(a_log[hh]); float dt0, dt1, ac0, ac1;
      chunk_decay(dtbuf, row0, hh, dt_bias[hh], Aneg, lane, dt0, dt1, ac0, ac1);
      LAS float* ac = (LAS float*)(lds + S3_AC) + w * 128; LAS float* dv = (LAS float*)(lds + S3_DT) + w * 128;
      ac[2 * lane] = ac0; ac[2 * lane + 1] = ac1; dv[2 * lane] = dt0; dv[2 * lane + 1] = dt1; }
#pragma unroll 1
    for (int which = 0; which < 2; ++which) { const int ch = tid & 15, xch = (which ? 2048 : 2560) + g * 128 + ch * 8; ConvW cw; conv_load_w(cw, conv_w, conv_b, xch);
        const int base = which ? S3_R : S3_CS;
#pragma unroll 1
        for (int i = 0; i < 4; ++i) { const int l = (tid >> 4) + 32 * i; float o[8]; conv8(P, row0 + l, xch, cw, o);
            u32x4 pw; pw.x = cvtpk(o[0], o[1]); pw.y = cvtpk(o[2], o[3]); pw.z = cvtpk(o[4], o[5]); pw.w = cvtpk(o[6], o[7]);
            *(LAS u32x4*)(lds + base + l * 272 + ch * 16) = pw; } }
    __syncthreads();
    bf16x8 cf[4];
#pragma unroll
    for (int ks = 0; ks < 4; ++ks) cf[ks] = *(const LAS bf16x8*)(lds + S3_CS + (16 * w + fr) * 272 + (32 * ks + 8 * kg) * 2);
    f32x4 cb[8];
#pragma unroll
    for (int ts = 0; ts < 8; ++ts) { f32x4 acc = {0.f, 0.f, 0.f, 0.f};
        if (ts <= w) {
#pragma unroll
            for (int ks = 0; ks < 4; ++ks) { const bf16x8 bfr = *(const LAS bf16x8*)(lds + S3_R + (16 * ts + fr) * 272 + (32 * ks + 8 * kg) * 2); acc = MFMA16(bfr, cf[ks], acc); } }
        cb[ts] = acc; }
    float ssq[4] = {0.f, 0.f, 0.f, 0.f};
    const int lme = 16 * w + fr;
#pragma unroll 1
    for (int hidx = 0; hidx < 8; ++hidx) {
        if ((hidx & 3) == 0) {
            __syncthreads();
            { const int half = hidx >> 2; const int ch = tid >> 4, xch = g * 512 + half * 256 + ch * 8; ConvW cw; conv_load_w(cw, conv_w, conv_b, xch);
#pragma unroll 1
              for (int i = 0; i < 8; ++i) { const int l = (tid & 15) + 16 * i; float o[8]; conv8(P, row0 + l, xch, cw, o);
                  LAS unsigned short* d = (LAS unsigned short*)(lds + S3_R + (ch * 8) * 272 + l * 2);
#pragma unroll
                  for (int e = 0; e < 8; e += 2) { const unsigned pw = cvtpk(o[e], o[e + 1]); d[e * 136] = (unsigned short)(pw & 0xffffu); d[(e + 1) * 136] = (unsigned short)(pw >> 16); } } }
            __syncthreads();
        }
        const int hl = hidx & 3, hh = 8 * g + hidx;
        const LAS float* ac = (const LAS float*)(lds + S3_AC) + hidx * 128; const LAS float* dv = (const LAS float*)(lds + S3_DT) + hidx * 128;
        const float acl = ac[lme];
        f32x4 accD[4], accO[4];
#pragma unroll
        for (int pt = 0; pt < 4; ++pt) { accD[pt] = (f32x4){0.f, 0.f, 0.f, 0.f}; accO[pt] = (f32x4){0.f, 0.f, 0.f, 0.f}; }
#pragma unroll
        for (int ks = 0; ks < 4; ++ks) {
            if (2 * ks <= w) { float mv[8];
#pragma unroll
                for (int tsub = 0; tsub < 2; ++tsub) { const int ts = 2 * ks + tsub; const f32x4 as = *(const LAS f32x4*)(ac + 16 * ts + 4 * kg), ds = *(const LAS f32x4*)(dv + 16 * ts + 4 * kg);
#pragma unroll
                    for (int j = 0; j < 4; ++j) { const int sidx = 16 * ts + 4 * kg + j; mv[4 * tsub + j] = (sidx <= lme) ? cb[ts][j] * __expf(acl - as[j]) * ds[j] : 0.f; } }
                u32x4 mw; mw.x = cvtpk(mv[0], mv[1]); mw.y = cvtpk(mv[2], mv[3]); mw.z = cvtpk(mv[4], mv[5]); mw.w = cvtpk(mv[6], mv[7]);
                const bf16x8 mf = __builtin_bit_cast(bf16x8, mw);
#pragma unroll
                for (int pt = 0; pt < 4; ++pt) { const int chan = hl * 64 + 16 * pt + fr;
                    const u32x2 lo = *(const LAS u32x2*)(lds + S3_R + chan * 272 + (32 * ks + 4 * kg) * 2), hi = *(const LAS u32x2*)(lds + S3_R + chan * 272 + (32 * ks + 16 + 4 * kg) * 2);
                    const u32x4 xw = {lo.x, lo.y, hi.x, hi.y}; accD[pt] = MFMA16(mf, __builtin_bit_cast(bf16x8, xw), accD[pt]); } } }
#pragma unroll
        for (int pt = 0; pt < 4; ++pt) { const bf16* pp = states + ((size_t)(c * 32 + hh) * 64 + 16 * pt + fr) * 128 + 8 * kg;
#pragma unroll
            for (int ks = 0; ks < 4; ++ks) { const bf16x8 pf = *(const bf16x8*)(pp + 32 * ks); accO[pt] = MFMA16(cf[ks], pf, accO[pt]); }
            asm volatile("" ::: "memory"); }
        const f32x4 al = *(const LAS f32x4*)(ac + 16 * w + 4 * kg); f32x4 ea;
#pragma unroll
        for (int j = 0; j < 4; ++j) ea[j] = __expf(al[j]);
        const float Dh = d_skip[hh];
#pragma unroll
        for (int pt = 0; pt < 4; ++pt) { const u32x2 xv = *(const LAS u32x2*)(lds + S3_R + (hl * 64 + 16 * pt + fr) * 272 + (16 * w + 4 * kg) * 2);
            const float xs[4] = {bflo(xv.x), bfhi(xv.x), bflo(xv.y), bfhi(xv.y)};
            bf16* zp = P + (size_t)(row0 + 16 * w + 4 * kg) * LDP + PC_Z + hh * 64 + 16 * pt + fr;
#pragma unroll
            for (int j = 0; j < 4; ++j) { const float y = accD[pt][j] + ea[j] * accO[pt][j] + Dh * xs[j]; const float z = __uint_as_float((unsigned)zp[(size_t)j * LDP] << 16);
                const unsigned ub = cvtpk(y * siluf_(z), 0.f) & 0xffffu; const float ur = __uint_as_float(ub << 16); ssq[j] += ur * ur; zp[(size_t)j * LDP] = (bf16)ub; } }
    }
    float rs[4];
#pragma unroll
    for (int j = 0; j < 4; ++j) { float v = ssq[j]; v += __shfl_xor(v, 1); v += __shfl_xor(v, 2); v += __shfl_xor(v, 4); v += __shfl_xor(v, 8); rs[j] = 1.0f / sqrtf(v * (1.0f / 512.0f) + RMS_EPS); }
#pragma unroll 1
    for (int hidx = 0; hidx < 8; ++hidx)
#pragma unroll
        for (int pt = 0; pt < 4; ++pt) { const int col = (8 * g + hidx) * 64 + 16 * pt + fr; const float nw = norm_w[col];
            bf16* up = P + (size_t)(row0 + 16 * w + 4 * kg) * LDP + PC_Z + col;
#pragma unroll
            for (int j = 0; j < 4; ++j) { const float u = __uint_as_float((unsigned)up[(size_t)j * LDP] << 16); up[(size_t)j * LDP] = (bf16)(cvtpk(u * rs[j] * nw, 0.f) & 0xffffu); } }
    __syncthreads();
}
struct Args { const float* in[24]; float* out; unsigned char* ws; };
__global__ void __launch_bounds__(NTHR, 2) mega_fwd(Args a) {
    extern __shared__ __attribute__((aligned(16))) unsigned char lds_raw[];
    LAS unsigned char* lds = (LAS unsigned char*)lds_raw;
    cg::grid_group grid = cg::this_grid();
    const int tid = threadIdx.x, lane = tid & 63, wave = __builtin_amdgcn_readfirstlane(tid >> 6);
    const int G = gridDim.x, bid = blockIdx.x, gw = bid * NWAVES + wave, NGW = G * NWAVES, gtid = bid * NTHR + tid, nthr = G * NTHR;
    unsigned char* ws = a.ws; unsigned char* dob = (unsigned char*)a.out;
    const float* x = a.in[0];
    bf16* Wgu = (bf16*)(ws + WS_WGU); bf16* Wd = (bf16*)(ws + WS_WD); bf16* Win = (bf16*)(ws + WS_WIN); bf16* Wcat = (bf16*)(ws + WS_WCAT); bf16* Wout = (bf16*)(ws + WS_WOUT);
    float* x1f = (float*)(ws + WS_X1F); bf16* big = (bf16*)(ws + WS_BIG); float* dtbuf = (float*)(ws + WS_DT); float* dec = (float*)(ws + WS_DEC);
    bf16* xb = (bf16*)(dob + DO_XB); bf16* states = (bf16*)(dob + DO_ST);
    LAS float* scr = (LAS float*)(lds + wave * 16384);
    volatile LAS unsigned* MISC = (volatile LAS unsigned*)(lds + LDS_BYTES - 64);
    if (tid < 16) MISC[tid] = 0u;
    __syncthreads();
    XcdBarrier bar = xcd_barrier_post((unsigned*)(ws + WS_CTL) , MISC + 8);

    ffn_weight_items(a.in[1], a.in[2], a.in[3], Wgu, Wd, scr, gw, NGW, lane);
    for (int it = gw; it < 16 * 273; it += NGW) { const int kb = it / 273, nb = it % 273, n0 = nb * 32; tr_item(a.in[6], 8736, kb * 64, n0, Win, 1024, map_in(n0), kb * 64, scr, lane); }
    for (int it = gw; it < 512 + 1024 + 512; it += NGW) { int r = it;
        if (r < 512) { tr_item(a.in[14], 1024, (r >> 5) * 64, (r & 31) * 32, Wcat, 1024, (r & 31) * 32, (r >> 5) * 64, scr, lane); continue; } r -= 512;
        if (r < 1024) { tr_item(a.in[15], 1024, (r >> 5) * 64, (r & 31) * 32, Wcat + (size_t)1024 * 1024, 2048, (r & 31) * 32, (r >> 5) * 64, scr, lane); continue; } r -= 1024;
        tr_item(a.in[16], 1024, (r >> 5) * 64, (r & 31) * 32, Wout, 1024, (r & 31) * 32, (r >> 5) * 64, scr, lane); }
    for (int i = gtid; i < 224 * 1024 / 8; i += nthr) *((u32x4*)(Win + (size_t)8736 * 1024) + i) = (u32x4){0u, 0u, 0u, 0u};
    for (int i = gtid; i < M * 1024 / 8; i += nthr) { const f32x4 v0 = *((const f32x4*)x + 2 * (size_t)i), v1 = *((const f32x4*)x + 2 * (size_t)i + 1);
        u32x4 o; o.x = cvtpk(v0.x, v0.y); o.y = cvtpk(v0.z, v0.w); o.z = cvtpk(v1.x, v1.y); o.w = cvtpk(v1.z, v1.w); *((u32x4*)xb + i) = o; }
    grid.sync();
#ifndef SKIP_GEMM1
    { pg8::Gemm g{xb, Wgu, M, 2 * DFF, 1024, 1024}; pg8::StaticOrder S; S.init(M, 2 * DFF, G, bid); pg8::EpiSwiGLU E{0, big, DFF};
      pg8::gemm_phase<pg8::EpiSwiGLU, pg8::StaticOrder, true, true>(lds, g, S, E); }
#endif
    xcd_barrier(bar);
#ifndef SKIP_GEMM2
    { pg8::Gemm g{big, Wd, M, 1024, DFF, DFF}; pg8::StaticOrder S; S.init(M, 1024, G, bid); pg8::EpiResid E{0, x, x1f, 1024, ALPHA, 0.5f};
      pg8::gemm_phase<pg8::EpiResid, pg8::StaticOrder, true, true>(lds, g, S, E); }
#endif
    xcd_barrier(bar);
    ln_rows(x1f, x1f, xb, a.in[4], a.in[5], M, gw, NGW, lane);
    xcd_barrier(bar);
#pragma unroll 1
    for (int b = 0; b < 2; ++b) {
#ifndef SKIP_GEMM3
        { pg8::Gemm g{xb + (size_t)b * MB * 1024, Win, MB, NPROJ, 1024, 1024}; pg8::StaticOrder S; S.init(MB, NPROJ, G, bid); pg8::EpiInProj E{0, big, LDP, dtbuf};
          pg8::gemm_phase<pg8::EpiInProj, pg8::StaticOrder, true, true>(lds, g, S, E); }
#endif
        xcd_barrier(bar);
#ifndef SKIP_S1
        for (int u = bid; u < 256; u += G) s1_unit(lds, big, dtbuf, dec, states, u >> 2, u & 3, a.in[7], a.in[8], a.in[9], a.in[10], tid);
#endif
#ifndef SKIP_ATTN
        for (int u = bid; u < 1024; u += G) attn_unit(lds, big, u >> 4, u & 15, a.in[13][u & 15], tid);
#endif
        xcd_barrier(bar);
        scan_phase(states, dec, gtid, nthr);
        xcd_barrier(bar);
#ifndef SKIP_S3
        for (int u = bid; u < 256; u += G) s3_unit(lds, big, dtbuf, states, u >> 2, u & 3, a.in[7], a.in[8], a.in[9], a.in[10], a.in[11], a.in[12], tid);
#endif
        xcd_barrier(bar);
#ifndef SKIP_G4
        { pg8::Gemm g{big + PC_Q, Wcat, MB, 1024, 1024, LDP}; pg8::StaticOrder S; S.init(MB, 1024, G, bid); pg8::EpiGate<0> E{0, big + PC_GA, LDP, PC_GS - PC_GA};
          pg8::gemm_phase<pg8::EpiGate<0>, pg8::StaticOrder, true, true>(lds, g, S, E); }
        { pg8::Gemm g{big + PC_Z, Wcat + (size_t)1024 * 1024, MB, 1024, 2048, LDP}; pg8::StaticOrder S; S.init(MB, 1024, G, bid); pg8::EpiGate<1> E{0, big + PC_GA, LDP, PC_GS - PC_GA};
          pg8::gemm_phase<pg8::EpiGate<1>, pg8::StaticOrder, true, true>(lds, g, S, E); }
#endif
        xcd_barrier(bar);
#ifndef SKIP_GEMM4
        { float* xr = x1f + (size_t)b * MB * 1024; pg8::Gemm g{big + PC_GA, Wout, MB, 1024, 1024, LDP}; pg8::StaticOrder S; S.init(MB, 1024, G, bid); pg8::EpiResid E{0, xr, xr, 1024, ALPHA, 1.0f};
          pg8::gemm_phase<pg8::EpiResid, pg8::StaticOrder, true, true>(lds, g, S, E); }
#endif
        xcd_barrier(bar);
    }
    ffn_weight_items(a.in[19], a.in[20], a.in[21], Wgu, Wd, scr, gw, NGW, lane);
    ln_rows(x1f, x1f, xb, a.in[17], a.in[18], M, gw, NGW, lane);
    xcd_barrier(bar);
#ifndef SKIP_GEMM5
    { pg8::Gemm g{xb, Wgu, M, 2 * DFF, 1024, 1024}; pg8::StaticOrder S; S.init(M, 2 * DFF, G, bid); pg8::EpiSwiGLU E{0, big, DFF};
      pg8::gemm_phase<pg8::EpiSwiGLU, pg8::StaticOrder, true, true>(lds, g, S, E); }
#endif
    xcd_barrier(bar);
#ifndef SKIP_GEMM6
    { pg8::Gemm g{big, Wd, M, 1024, DFF, DFF}; pg8::StaticOrder S; S.init(M, 1024, G, bid); pg8::EpiResid E{0, x1f, a.out, 1024, ALPHA, 0.5f};
      pg8::gemm_phase<pg8::EpiResid, pg8::StaticOrder, true, true>(lds, g, S, E); }
#endif
    xcd_barrier(bar);
    ln_rows(a.out, a.out, nullptr, a.in[22], a.in[23], M, gw, NGW, lane);
}

extern "C" void kernel_launch(void* const* d_in, const int* in_sizes, int n_in, void* d_out, int out_size, void* d_ws, size_t ws_size, hipStream_t stream) {
    static int grid = 0;
    if (grid == 0) {
        if (n_in != 24 || out_size != M * 1024 || ws_size < WS_END) { fprintf(stderr, "kernel_launch: unexpected shapes (n_in %d out %d ws %zu)\n", n_in, out_size, ws_size); grid = -1; return; }
        int dev = 0, cus = 0, per_cu = 0;
        (void)hipGetDevice(&dev); (void)hipDeviceGetAttribute(&cus, hipDeviceAttributeMultiprocessorCount, dev);
        (void)hipFuncSetAttribute((const void*)mega_fwd, hipFuncAttributeMaxDynamicSharedMemorySize, LDS_BYTES);
        (void)hipOccupancyMaxActiveBlocksPerMultiprocessor(&per_cu, (const void*)mega_fwd, NTHR, LDS_BYTES);
        if (per_cu < 1) per_cu = 1;
        grid = cus * per_cu; if (grid > 256) grid = 256;
        (void)hipGetLastError();
    }
    if (grid < 0) return;
    if (hipMemsetAsync((char*)d_ws + WS_CTL, 0, 65536, stream) != hipSuccess) { fprintf(stderr, "memset failed\n"); return; }
    Args a{};
    for (int i = 0; i < 24; ++i) a.in[i] = (const float*)d_in[i];
    a.out = (float*)d_out; a.ws = (unsigned char*)d_ws;
    void* args[] = {&a};
    hipError_t e = hipLaunchCooperativeKernel((const void*)mega_fwd, dim3(grid), dim3(NTHR), args, LDS_BYTES, stream);
    if (e != hipSuccess) fprintf(stderr, "cooperative launch failed: %s (grid %d)\n", hipGetErrorString(e), grid);
}
```

```cpp
#include <hip/hip_runtime.h>
#include <hip/hip_cooperative_groups.h>
#include <cstdio>
#include <cstdint>
namespace cg = cooperative_groups;
namespace pg8 {
#define PG8_LAS __attribute__((address_space(3)))
typedef unsigned short bf16_t;
typedef short bf16x8 __attribute__((ext_vector_type(8)));
typedef float f32x4 __attribute__((ext_vector_type(4)));
typedef unsigned u32x4 __attribute__((ext_vector_type(4)));
constexpr int BM = 256, BK = 64, HALF = 128, HTB = HALF * BK * 2  , STAGE_BYTES = 8 * HTB, NXCD = 8, WGM = 8;

__host__ __device__ __forceinline__ int lds_byte(int r, int c) { const int st = (r >> 4) * 2 + (c >> 5), rr = r & 15, cc = c & 31, ob = rr * 64 + cc * 2; return st * 1024 + (ob ^ (((ob >> 9) & 1) << 5)); }
__host__ __device__ __forceinline__ void stage_rc(int b, int& R, int& C) { const int st = b / 1024, sb = b % 1024, swz = sb ^ (((sb >> 9) & 1) << 5); R = (st >> 1) * 16 + swz / 64; C = (st & 1) * 32 + (swz % 64) / 2; }
__host__ __device__ __forceinline__ int perm32(int rho) { const int n = rho >> 4, i = rho & 15; return 8 * (i >> 2) + 4 * n + (i & 3); }

struct Unit { int pm, pn; };
struct Gemm { const bf16_t* A; const bf16_t* Bt; int M, N, K, lda; };

struct StaticOrder {
    int nM, nN, nwg, G, c;
    __host__ __device__ void init(int M, int N, int G_, int c_) { nM = M / BM; nN = N / BM; nwg = nM * nN; G = G_; c = c_; }
    __host__ __device__ bool next(int i, Unit& u) const {
        const long L = (long)i * G + c; if (L >= nwg) return false;
        int wgid = (int)L; { const int q = nwg / NXCD, r = nwg % NXCD, xcd = wgid % NXCD, off = wgid / NXCD; wgid = (xcd < r ? xcd * (q + 1) : r * (q + 1) + (xcd - r) * q) + off; }
        const int nig = WGM * nN, gid = wgid / nig, fm = gid * WGM, gsz = (nM - fm) < WGM ? (nM - fm) : WGM;
        u.pm = fm + ((wgid % nig) % gsz); u.pn = (wgid % nig) / gsz; return true;
    }
    __device__ __forceinline__ void a_ready(const Unit&) const {}
    __device__ __forceinline__ void done(const Unit&) const {}
};

typedef float f32x2_t __attribute__((ext_vector_type(2))); typedef __bf16 bf16x2_t __attribute__((ext_vector_type(2)));
__device__ __forceinline__ unsigned cvtpk(float lo, float hi) { f32x2_t v = {lo, hi}; bf16x2_t b = __builtin_convertvector(v, bf16x2_t); return __builtin_bit_cast(unsigned, b); }
__device__ __forceinline__ float bflo(unsigned w) { return __uint_as_float(w << 16); }
__device__ __forceinline__ float bfhi(unsigned w) { return __uint_as_float(w & 0xffff0000u); }
__device__ __forceinline__ float sigmoidf_(float x) { return __builtin_amdgcn_rcpf(1.0f + __builtin_amdgcn_exp2f(-1.4426950408889634f * x)); }
__device__ __forceinline__ float siluf_(float x) { return x * sigmoidf_(x); }

struct EpiSwiGLU {
    static constexpr bool PERM = true, AFTER_DRAIN = false, HAS_MID = false; int mid_t;
    bf16_t* O; int ldc;
    __device__ __forceinline__ void mid(f32x4 (&)[2][2][4][2], const Unit&, int, int, int, int) const {}
    __device__ __forceinline__ void operator()(const f32x4 (&acc)[2][2][4][2], const Unit& u, int wr, int wc, int fr, int fq) const {
        const int row0 = u.pm * BM + wr * 64 + fr, col0 = u.pn * HALF + wc * 32 + 8 * fq;
#pragma unroll
        for (int ai = 0; ai < 2; ++ai)
#pragma unroll
            for (int m = 0; m < 4; ++m) { bf16_t* rowp = O + (size_t)(row0 + ai * HALF + m * 16) * ldc + col0;
                const f32x4 g0 = acc[ai][0][m][0], g1 = acc[ai][0][m][1], u0 = acc[ai][1][m][0], u1 = acc[ai][1][m][1];
                u32x4 w; w.x = cvtpk(siluf_(g0[0]) * u0[0], siluf_(g0[1]) * u0[1]); w.y = cvtpk(siluf_(g0[2]) * u0[2], siluf_(g0[3]) * u0[3]);
                w.z = cvtpk(siluf_(g1[0]) * u1[0], siluf_(g1[1]) * u1[1]); w.w = cvtpk(siluf_(g1[2]) * u1[2], siluf_(g1[3]) * u1[3]);
                *(u32x4*)rowp = w; }
    }
};
struct EpiResid {
    static constexpr bool PERM = false, AFTER_DRAIN = false, HAS_MID = false; int mid_t;
    const float* res; float* out; int ldc; float alpha, s;
    __device__ __forceinline__ void mid(f32x4 (&)[2][2][4][2], const Unit&, int, int, int, int) const {}
    __device__ __forceinline__ void operator()(const f32x4 (&acc)[2][2][4][2], const Unit& u, int wr, int wc, int fr, int fq) const {
        const int row0 = u.pm * BM + wr * 64 + fr, col0 = u.pn * BM + wc * 32 + 4 * fq;
#pragma unroll
        for (int ai = 0; ai < 2; ++ai)
#pragma unroll
            for (int m = 0; m < 4; ++m) { const size_t off = (size_t)(row0 + ai * HALF + m * 16) * ldc + col0;
#pragma unroll
                for (int bj = 0; bj < 2; ++bj)
#pragma unroll
                    for (int n = 0; n < 2; ++n) { const f32x4 r = *(const f32x4*)(res + off + bj * HALF + n * 16); *(f32x4*)(out + off + bj * HALF + n * 16) = r * alpha + acc[ai][bj][m][n] * s; } }
    }
};
struct EpiInProj {
    static constexpr bool PERM = true, AFTER_DRAIN = false, HAS_MID = false; int mid_t;
    bf16_t* O; int ldc; float* dt;
    __device__ __forceinline__ void mid(f32x4 (&)[2][2][4][2], const Unit&, int, int, int, int) const {}
    __device__ __forceinline__ void operator()(const f32x4 (&acc)[2][2][4][2], const Unit& u, int wr, int wc, int fr, int fq) const {
        const int row0 = u.pm * BM + wr * 64 + fr;
        if (u.pn == 34) {
            if (wc == 0) {
#pragma unroll
                for (int ai = 0; ai < 2; ++ai)
#pragma unroll
                    for (int m = 0; m < 4; ++m) { float* p = dt + (size_t)(row0 + ai * HALF + m * 16) * 32 + 8 * fq; *(f32x4*)p = acc[ai][0][m][0]; *(f32x4*)(p + 4) = acc[ai][0][m][1]; }
            }
            return;
        }
        const bool gate = u.pn >= 26; const int col0 = u.pn * BM + wc * 32 + 8 * fq;
#pragma unroll
        for (int ai = 0; ai < 2; ++ai)
#pragma unroll
            for (int m = 0; m < 4; ++m) { bf16_t* rowp = O + (size_t)(row0 + ai * HALF + m * 16) * ldc + col0;
#pragma unroll
                for (int bj = 0; bj < 2; ++bj) { f32x4 v0 = acc[ai][bj][m][0], v1 = acc[ai][bj][m][1];
                    if (gate) {
#pragma unroll
                        for (int i = 0; i < 4; ++i) { v0[i] = sigmoidf_(v0[i]); v1[i] = sigmoidf_(v1[i]); } }
                    u32x4 w; w.x = cvtpk(v0[0], v0[1]); w.y = cvtpk(v0[2], v0[3]); w.z = cvtpk(v1[0], v1[1]); w.w = cvtpk(v1[2], v1[3]);
                    *(u32x4*)(rowp + bj * HALF) = w; } }
    }
};
template <int MODE> struct EpiGate {
    static constexpr bool PERM = true, AFTER_DRAIN = false, HAS_MID = false; int mid_t;
    bf16_t* G; int ldc; int gsoff;
    __device__ __forceinline__ void mid(f32x4 (&)[2][2][4][2], const Unit&, int, int, int, int) const {}
    __device__ __forceinline__ void operator()(const f32x4 (&acc)[2][2][4][2], const Unit& u, int wr, int wc, int fr, int fq) const {
        const int row0 = u.pm * BM + wr * 64 + fr, col0 = u.pn * BM + wc * 32 + 8 * fq;
#pragma unroll
        for (int ai = 0; ai < 2; ++ai)
#pragma unroll
            for (int m = 0; m < 4; ++m) { bf16_t* rowp = G + (size_t)(row0 + ai * HALF + m * 16) * ldc + col0;
#pragma unroll
                for (int bj = 0; bj < 2; ++bj) { const u32x4 t = *(const u32x4*)(rowp + bj * HALF); const f32x4 v0 = acc[ai][bj][m][0], v1 = acc[ai][bj][m][1]; u32x4 w;
                    if (MODE == 0) { w.x = cvtpk(v0[0] * bflo(t.x), v0[1] * bfhi(t.x)); w.y = cvtpk(v0[2] * bflo(t.y), v0[3] * bfhi(t.y));
                        w.z = cvtpk(v1[0] * bflo(t.z), v1[1] * bfhi(t.z)); w.w = cvtpk(v1[2] * bflo(t.w), v1[3] * bfhi(t.w)); }
                    else { const u32x4 s = *(const u32x4*)(rowp + bj * HALF + gsoff);
                        w.x = cvtpk(bflo(t.x) + v0[0] * bflo(s.x), bfhi(t.x) + v0[1] * bfhi(s.x)); w.y = cvtpk(bflo(t.y) + v0[2] * bflo(s.y), bfhi(t.y) + v0[3] * bfhi(s.y));
                        w.z = cvtpk(bflo(t.z) + v1[0] * bflo(s.z), bfhi(t.z) + v1[1] * bfhi(s.z)); w.w = cvtpk(bflo(t.w) + v1[2] * bflo(s.w), bfhi(t.w) + v1[3] * bfhi(s.w)); }
                    *(u32x4*)(rowp + bj * HALF) = w; } }
    }
};
template <class Epi, class Sched, bool ALIGN_EPI = false, bool SP2 = false>
__device__ __forceinline__ void gemm_phase(PG8_LAS unsigned char* lds, const Gemm g, const Sched& S, const Epi& E) {
    int tid_ = threadIdx.x; asm volatile("" : "+v"(tid_)); const int tid = tid_, wid = __builtin_amdgcn_readfirstlane(tid >> 6), lane = tid & 63, wr = wid >> 2, wc = wid & 3, fr = lane & 15, fq = lane >> 4;
    const int K = g.K, nt = K / BK;
    unsigned voffA[2], voffB[2];
#pragma unroll
    for (int i = 0; i < 2; ++i) { int R, C; stage_rc(tid * 16 + i * 8192, R, C); const int Rb = Epi::PERM ? ((R & ~31) + perm32(R & 31)) : R;
        voffA[i] = (unsigned)(R * g.lda + C) * 2u; voffB[i] = (unsigned)(Rb * K + C) * 2u; }
    const size_t kstep = (size_t)(BK * 2);
    const size_t hstepB = (size_t)HALF * K * 2, hstepA = (size_t)HALF * g.lda * 2;
    const size_t tstepA = 2 * hstepA, tstepB = 2 * hstepB;
    const unsigned ldsw = (unsigned)wid * 1024u;
    const int aoff = lds_byte(wr * 64 + fr, fq * 8), boff = lds_byte(wc * 32 + fr, fq * 8);
#define PG8_SA(b, h) (((b) * 2 + (h)) * HTB)
#define PG8_SB(b, h) ((4 + (b) * 2 + (h)) * HTB)
#define PG8_STAGE(bufoff, gbase, voff) do { _Pragma("unroll") for (int _i = 0; _i < 2; ++_i) \
        __builtin_amdgcn_global_load_lds((const unsigned*)((const char*)(gbase) + (voff)[_i]), (PG8_LAS unsigned*)(lds + (bufoff) + ldsw + _i * 8192), 16, 0, 0); } while (0)
#define PG8_LDA(dst, b, h) do { _Pragma("unroll") for (int m = 0; m < 4; ++m) _Pragma("unroll") for (int k = 0; k < 2; ++k) dst[m][k] = *(const PG8_LAS bf16x8*)(lds + PG8_SA(b, h) + aoff + m * 2048 + k * 1024); } while (0)
#define PG8_LDB(dst, b, h) do { _Pragma("unroll") for (int n = 0; n < 2; ++n) _Pragma("unroll") for (int k = 0; k < 2; ++k) dst[n][k] = *(const PG8_LAS bf16x8*)(lds + PG8_SB(b, h) + boff + n * 2048 + k * 1024); } while (0)
#define PG8_MMA(ai, bj, At, Bt) do { __builtin_amdgcn_s_setprio(1); _Pragma("unroll") for (int m = 0; m < 4; ++m) _Pragma("unroll") for (int n = 0; n < 2; ++n) _Pragma("unroll") for (int k = 0; k < 2; ++k) \
        acc[ai][bj][m][n] = __builtin_amdgcn_mfma_f32_16x16x32_bf16(Bt[n][k], At[m][k], acc[ai][bj][m][n], 0, 0, 0); __builtin_amdgcn_s_setprio(0); } while (0)
#define PG8_WAIT_V(n) asm volatile("s_waitcnt vmcnt(" #n ")" ::: "memory")
#define PG8_WAIT_L(n) asm volatile("s_waitcnt lgkmcnt(" #n ")" ::: "memory")
#define PG8_BAR __builtin_amdgcn_s_barrier()
#define PG8_SCHED __builtin_amdgcn_sched_barrier(0)
    Unit cur, nxt; int ui = 0;
    if (!S.next(0, cur)) return;
    f32x4 acc[2][2][4][2];
#pragma unroll
    for (int a = 0; a < 2; ++a)
#pragma unroll
        for (int b = 0; b < 2; ++b)
#pragma unroll
            for (int m = 0; m < 4; ++m)
#pragma unroll
                for (int n = 0; n < 2; ++n) acc[a][b][m][n] = (f32x4){0.f, 0.f, 0.f, 0.f};
    bf16x8 At[4][2], B0[2][2], B1[2][2];
    const char* cA = (const char*)g.A + (size_t)cur.pm * tstepA; const char* cB = (const char*)g.Bt + (size_t)cur.pn * tstepB;
    S.a_ready(cur);
    if constexpr (SP2) {
        PG8_STAGE(PG8_SB(0, 0), cB, voffB); PG8_STAGE(PG8_SB(0, 1), cB + hstepB, voffB); PG8_STAGE(PG8_SA(0, 0), cA, voffA); PG8_STAGE(PG8_SA(0, 1), cA + hstepA, voffA);
        if (wr == 1) PG8_BAR;
        PG8_WAIT_V(2); PG8_BAR;
        PG8_STAGE(PG8_SB(1, 0), cB + kstep, voffB); PG8_STAGE(PG8_SA(1, 0), cA + kstep, voffA); PG8_STAGE(PG8_SB(1, 1), cB + hstepB + kstep, voffB);
        PG8_WAIT_V(6); PG8_BAR;
    } else {
        PG8_STAGE(PG8_SB(0, 0), cB, voffB); PG8_STAGE(PG8_SA(0, 0), cA, voffA); PG8_STAGE(PG8_SB(0, 1), cB + hstepB, voffB); PG8_STAGE(PG8_SA(0, 1), cA + hstepA, voffA);
        if (wr == 1) PG8_BAR;
        PG8_WAIT_V(4); PG8_BAR;
        PG8_STAGE(PG8_SB(1, 0), cB + kstep, voffB); PG8_STAGE(PG8_SA(1, 0), cA + kstep, voffA); PG8_STAGE(PG8_SB(1, 1), cB + hstepB + kstep, voffB);
        PG8_WAIT_V(6); PG8_BAR;
    }
    for (;;) {
        const bool has_next = S.next(ui + 1, nxt);
        const char* nA = has_next ? (const char*)g.A + (size_t)nxt.pm * tstepA : cA; const char* nB = has_next ? (const char*)g.Bt + (size_t)nxt.pn * tstepB : cB;
        for (int t = 0; t < nt; t += 2) {
            if constexpr (Epi::HAS_MID) { if (t == E.mid_t) E.mid(acc, cur, wr, wc, fr, fq); }
            const bool last = (t == nt - 2);
            const char* a1 = cA + (size_t)(t + 1) * kstep;
            const char* a2 = last ? nA : cA + (size_t)(t + 2) * kstep; const char* b2 = last ? nB : cB + (size_t)(t + 2) * kstep;
            const char* a3 = a2 + kstep; const char* b3 = b2 + kstep;
            if (last && has_next) S.a_ready(nxt);
            if constexpr (SP2) {
            PG8_LDB(B0, 0, 0); PG8_LDB(B1, 0, 1); PG8_SCHED; PG8_LDA(At, 0, 0); PG8_STAGE(PG8_SA(1, 1), a1 + hstepA, voffA);
            PG8_WAIT_V(8); PG8_WAIT_L(0); PG8_BAR; PG8_MMA(0, 0, At, B0); PG8_MMA(0, 1, At, B1); PG8_BAR; PG8_SCHED;
            PG8_LDA(At, 0, 1); PG8_STAGE(PG8_SB(0, 0), b2, voffB); PG8_STAGE(PG8_SB(0, 1), b2 + hstepB, voffB); PG8_STAGE(PG8_SA(0, 0), a2, voffA);
            PG8_WAIT_V(8); PG8_WAIT_L(0); PG8_BAR; PG8_MMA(1, 0, At, B0); PG8_MMA(1, 1, At, B1); PG8_BAR; PG8_SCHED;
            PG8_LDB(B0, 1, 0); PG8_LDB(B1, 1, 1); PG8_SCHED; PG8_LDA(At, 1, 0); PG8_STAGE(PG8_SA(0, 1), a2 + hstepA, voffA);
            PG8_WAIT_V(8); PG8_WAIT_L(0); PG8_BAR; PG8_MMA(0, 0, At, B0); PG8_MMA(0, 1, At, B1); PG8_BAR; PG8_SCHED;
            PG8_LDA(At, 1, 1); PG8_STAGE(PG8_SB(1, 0), b3, voffB); PG8_STAGE(PG8_SB(1, 1), b3 + hstepB, voffB); PG8_STAGE(PG8_SA(1, 0), a3, voffA);
            PG8_WAIT_V(8); PG8_WAIT_L(0); PG8_BAR; PG8_MMA(1, 0, At, B0); PG8_MMA(1, 1, At, B1); PG8_BAR; PG8_SCHED;
            } else {
            PG8_LDB(B0, 0, 0); PG8_SCHED; PG8_LDA(At, 0, 0); PG8_STAGE(PG8_SA(1, 1), a1 + hstepA, voffA);
            PG8_WAIT_L(8); PG8_BAR; PG8_WAIT_L(0); PG8_MMA(0, 0, At, B0); PG8_BAR; PG8_SCHED;
            PG8_LDB(B1, 0, 1); PG8_STAGE(PG8_SB(0, 0), b2, voffB);
            PG8_BAR; PG8_WAIT_L(0); PG8_MMA(0, 1, At, B1); PG8_BAR;
            PG8_LDA(At, 0, 1); PG8_STAGE(PG8_SA(0, 0), a2, voffA);
            PG8_BAR; PG8_WAIT_L(0); PG8_MMA(1, 0, At, B0); PG8_BAR; PG8_SCHED;
            PG8_STAGE(PG8_SB(0, 1), b2 + hstepB, voffB);
            PG8_WAIT_V(6); PG8_BAR; PG8_MMA(1, 1, At, B1); PG8_BAR;
            PG8_LDB(B0, 1, 0); PG8_SCHED; PG8_LDA(At, 1, 0); PG8_STAGE(PG8_SA(0, 1), a2 + hstepA, voffA);
            PG8_WAIT_L(8); PG8_BAR; PG8_WAIT_L(0); PG8_MMA(0, 0, At, B0); PG8_BAR; PG8_SCHED;
            PG8_LDB(B1, 1, 1); PG8_STAGE(PG8_SB(1, 0), b3, voffB);
            PG8_BAR; PG8_WAIT_L(0); PG8_MMA(0, 1, At, B1); PG8_BAR;
            PG8_LDA(At, 1, 1); PG8_STAGE(PG8_SA(1, 0), a3, voffA);
            PG8_BAR; PG8_WAIT_L(0); PG8_MMA(1, 0, At, B0); PG8_BAR; PG8_SCHED;
            PG8_STAGE(PG8_SB(1, 1), b3 + hstepB, voffB);
            PG8_WAIT_V(6); PG8_BAR; PG8_MMA(1, 1, At, B1); PG8_BAR;
            }
        }
        if constexpr (ALIGN_EPI) { if (wr == 0) PG8_BAR; }
        if constexpr (!Epi::AFTER_DRAIN) { E(acc, cur, wr, wc, fr, fq); S.done(cur); }
        if (!has_next) break;
#pragma unroll
        for (int a = 0; a < 2; ++a)
#pragma unroll
            for (int b = 0; b < 2; ++b)
#pragma unroll
                for (int m = 0; m < 4; ++m)
#pragma unroll
                    for (int n = 0; n < 2; ++n) acc[a][b][m][n] = (f32x4){0.f, 0.f, 0.f, 0.f};
        cur = nxt; cA = nA; cB = nB; ++ui;
        if constexpr (ALIGN_EPI) { if (wr == 1) PG8_BAR; }
    }
    PG8_WAIT_V(0);
    if constexpr (!ALIGN_EPI) { if (wr == 0) PG8_BAR; }
    PG8_BAR;
    if constexpr (Epi::AFTER_DRAIN) { E.fused(acc, cur, wr, wc, fr, fq, lds, wid, lane); S.done(cur); }
#undef PG8_SA
#undef PG8_SB
#undef PG8_STAGE
#undef PG8_LDA
#undef PG8_LDB
#undef PG8_MMA
#undef PG8_WAIT_V
#undef PG8_WAIT_L
#undef PG8_BAR
#undef PG8_SCHED
}
}

#define LAS __attribute__((address_space(3)))
typedef unsigned short bf16;
typedef float f32x4 __attribute__((ext_vector_type(4)));
typedef short bf16x8 __attribute__((ext_vector_type(8)));
typedef short bf16x4 __attribute__((ext_vector_type(4)));
typedef unsigned u32x4 __attribute__((ext_vector_type(4)));
typedef unsigned u32x2 __attribute__((ext_vector_type(2)));
using pg8::cvtpk; using pg8::bflo; using pg8::bfhi; using pg8::siluf_; using pg8::sigmoidf_;
constexpr int NWAVES = 8, NTHR = 512;
constexpr int M = 16384, MB = 8192, DMODEL = 1024, DFF = 2816;
constexpr int LDP = 8704;
constexpr int PC_Q = 0, PC_Z = 1024, PC_K = 3072, PC_V = 3328, PC_XBC = 3584, PC_GA = 6656, PC_GS = 7680;
constexpr int NPROJ = 8960;
constexpr float LN_EPS = 1e-5f, RMS_EPS = 1e-5f;
constexpr float ALPHA = 1.189207115002721f;
constexpr size_t MiB = 1u << 20;
constexpr size_t WS_CTL = 0, WS_DEC = 512 * 1024, WS_DT = 1 * MiB, WS_WGU = 2 * MiB, WS_WD = 13 * MiB, WS_WIN = 19 * MiB, WS_WCAT = 37 * MiB, WS_WOUT = 43 * MiB, WS_X1F = 45 * MiB, WS_BIG = 109 * MiB, WS_END = 245 * MiB;
constexpr size_t DO_XB = 0, DO_ST = 32 * MiB;
constexpr int LDS_BYTES = 147456;

#define LDS_WAIT() asm volatile("s_waitcnt lgkmcnt(0)" ::: "memory")
#define MFMA16(a, b, c) __builtin_amdgcn_mfma_f32_16x16x32_bf16((a), (b), (c), 0, 0, 0)

__device__ __forceinline__ float wave_sum(float v) {
#pragma unroll
    for (int o = 1; o < 64; o <<= 1) v += __shfl_xor(v, o);
    return v;
}
__device__ __forceinline__ void tr_item(const float* W, int ldw, int k0, int n0, bf16* WT, int ldt, int drow, int dcol, LAS float* scr, int lane) {
#pragma unroll 8
    for (int i = 0; i < 32; ++i) { const int kk = 2 * i + (lane >> 5); scr[kk * 33 + (lane & 31)] = W[(size_t)(k0 + kk) * ldw + n0 + (lane & 31)]; }
    LDS_WAIT(); asm volatile("" ::: "memory");
    const int c = lane & 7;
#pragma unroll
    for (int j = 0; j < 4; ++j) { const int n = (lane >> 3) + 8 * j; const LAS float* s = scr + (8 * c) * 33 + n;
        u32x4 o; o.x = cvtpk(s[0 * 33], s[1 * 33]); o.y = cvtpk(s[2 * 33], s[3 * 33]); o.z = cvtpk(s[4 * 33], s[5 * 33]); o.w = cvtpk(s[6 * 33], s[7 * 33]);
        *(u32x4*)(WT + (size_t)(drow + n) * ldt + dcol + 8 * c) = o; }
    LDS_WAIT(); asm volatile("" ::: "memory");
}
__device__ __forceinline__ int map_in(int n0) {
    if (n0 < 1024) return n0;
    if (n0 < 1280) return PC_K + (n0 - 1024);
    if (n0 < 1536) return PC_V + (n0 - 1280);
    if (n0 < 3584) return PC_Z + (n0 - 1536);
    if (n0 < 6656) return n0;
    if (n0 < 6688) return 8704 + (n0 - 6656);
    if (n0 < 7712) return PC_GA + (n0 - 6688);
    return PC_GS + (n0 - 7712);
}
__device__ __forceinline__ void ffn_weight_items(const float* wg, const float* wu, const float* wd, bf16* Wgu, bf16* Wd, LAS float* scr, int gw, int NGW, int lane) {
    constexpr int I_G = 16 * 88, I_D = 44 * 32;
    for (int it = gw; it < 2 * I_G + I_D; it += NGW) {
        int r = it;
        if (r < 2 * I_G) { const bool up = r >= I_G; if (up) r -= I_G; const int kb = r / 88, nb = r % 88, n0 = nb * 32;
            tr_item(up ? wu : wg, DFF, kb * 64, n0, Wgu, 1024, (n0 >> 7) * 256 + (n0 & 127) + (up ? 128 : 0), kb * 64, scr, lane); continue; }
        r -= 2 * I_G; { const int kb = r / 32, nb = r % 32; tr_item(wd, 1024, kb * 64, nb * 32, Wd, DFF, nb * 32, kb * 64, scr, lane); }
    }
}
__device__ __forceinline__ void ln_rows(const float* src, float* dstf, bf16* dstb, const float* g, const float* b, int nrows, int gw, int NGW, int lane) {
    f32x4 gv[4], bv[4];
#pragma unroll
    for (int j = 0; j < 4; ++j) { gv[j] = *((const f32x4*)g + lane + 64 * j); bv[j] = *((const f32x4*)b + lane + 64 * j); }
    for (int m = gw; m < nrows; m += NGW) {
        const f32x4* xr = (const f32x4*)(src + (size_t)m * 1024) + lane;
        f32x4 v[4]; float s = 0.f;
#pragma unroll
        for (int j = 0; j < 4; ++j) { v[j] = xr[64 * j]; s += (v[j].x + v[j].y) + (v[j].z + v[j].w); }
        const float mean = wave_sum(s) * (1.f / 1024.f); float s2 = 0.f;
#pragma unroll
        for (int j = 0; j < 4; ++j) { v[j] = v[j] - mean; s2 += (v[j].x * v[j].x + v[j].y * v[j].y) + (v[j].z * v[j].z + v[j].w * v[j].w); }
        const float rstd = 1.f / sqrtf(wave_sum(s2) * (1.f / 1024.f) + LN_EPS);
#pragma unroll
        for (int j = 0; j < 4; ++j) { const f32x4 y = v[j] * rstd * gv[j] + bv[j];
            if (dstf) *((f32x4*)(dstf + (size_t)m * 1024) + lane + 64 * j) = y;
            if (dstb) { u32x2 w; w.x = cvtpk(y.x, y.y); w.y = cvtpk(y.z, y.w); *((u32x2*)(dstb + (size_t)m * 1024) + lane + 64 * j) = w; } }
    }
}
struct ConvW { f32x4 w[4][2]; f32x4 b[2]; };
__device__ __forceinline__ void conv_load_w(ConvW& cw, const float* conv_w, const float* conv_b, int xch) {
#pragma unroll
    for (int j = 0; j < 4; ++j) { cw.w[j][0] = *(const f32x4*)(conv_w + j * 3072 + xch); cw.w[j][1] = *(const f32x4*)(conv_w + j * 3072 + xch + 4); }
    cw.b[0] = *(const f32x4*)(conv_b + xch); cw.b[1] = *(const f32x4*)(conv_b + xch + 4);
}
__device__ __forceinline__ void conv8(const bf16* P, int row, int xch, const ConvW& cw, float (&o)[8]) {
    f32x4 a0 = cw.b[0], a1 = cw.b[1];
#pragma unroll
    for (int j = 0; j < 4; ++j) { const int r = row - 3 + j;
        if (r >= 0) { const u32x4 v = *(const u32x4*)(P + (size_t)r * LDP + PC_XBC + xch);
            a0[0] += cw.w[j][0][0] * bflo(v.x); a0[1] += cw.w[j][0][1] * bfhi(v.x); a0[2] += cw.w[j][0][2] * bflo(v.y); a0[3] += cw.w[j][0][3] * bfhi(v.y);
            a1[0] += cw.w[j][1][0] * bflo(v.z); a1[1] += cw.w[j][1][1] * bfhi(v.z); a1[2] += cw.w[j][1][2] * bflo(v.w); a1[3] += cw.w[j][1][3] * bfhi(v.w); } }
#pragma unroll
    for (int i = 0; i < 4; ++i) { o[i] = siluf_(a0[i]); o[4 + i] = siluf_(a1[i]); }
}
template <bool TR> __device__ __forceinline__ void conv_tile8(LAS unsigned char* dst, const bf16* P, int row0, int xch, int cgl, int lr,
                                                           const float* conv_w, const float* conv_b, const LAS float* sw) {
    ConvW cw; conv_load_w(cw, conv_w, conv_b, xch);
    u32x4 raw[11];
#pragma unroll
    for (int k = 0; k < 11; ++k) { const int r = row0 + lr * 8 - 3 + k; raw[k] = (r >= 0) ? *(const u32x4*)(P + (size_t)r * LDP + PC_XBC + xch) : (u32x4){0u, 0u, 0u, 0u}; }
    unsigned pk[8][2];
#pragma unroll
    for (int lp = 0; lp < 4; ++lp) { float o[2][8];
#pragma unroll
        for (int q = 0; q < 2; ++q) { f32x4 a0 = cw.b[0], a1 = cw.b[1];
#pragma unroll
            for (int j = 0; j < 4; ++j) { const u32x4 v = raw[2 * lp + q + j];
                a0[0] += cw.w[j][0][0] * bflo(v.x); a0[1] += cw.w[j][0][1] * bfhi(v.x); a0[2] += cw.w[j][0][2] * bflo(v.y); a0[3] += cw.w[j][0][3] * bfhi(v.y);
                a1[0] += cw.w[j][1][0] * bflo(v.z); a1[1] += cw.w[j][1][1] * bfhi(v.z); a1[2] += cw.w[j][1][2] * bflo(v.w); a1[3] += cw.w[j][1][3] * bfhi(v.w); }
            const float sc = sw ? sw[lr * 8 + 2 * lp + q] : 1.0f;
#pragma unroll
            for (int i = 0; i < 4; ++i) { o[q][i] = siluf_(a0[i]) * sc; o[q][4 + i] = siluf_(a1[i]) * sc; } }
        if (TR) {
#pragma unroll
            for (int e = 0; e < 8; ++e) pk[e][lp & 1] = cvtpk(o[0][e], o[1][e]);
            if (lp & 1) {
#pragma unroll
                for (int e = 0; e < 8; ++e) *(LAS u32x2*)(dst + (cgl * 8 + e) * 272 + lr * 16 + (lp >> 1) * 8) = (u32x2){pk[e][0], pk[e][1]}; }
        } else {
#pragma unroll
            for (int q = 0; q < 2; ++q) { u32x4 pw; pw.x = cvtpk(o[q][0], o[q][1]); pw.y = cvtpk(o[q][2], o[q][3]); pw.z = cvtpk(o[q][4], o[q][5]); pw.w = cvtpk(o[q][6], o[q][7]);
                *(LAS u32x4*)(dst + (lr * 8 + 2 * lp + q) * 272 + cgl * 16) = pw; } } }
}
__device__ __forceinline__ void chunk_decay(const float* dtbuf, int row0, int head, float bias, float Aneg, int lane, float& dt0, float& dt1, float& ac0, float& ac1) {
    float r0 = dtbuf[(size_t)(row0 + 2 * lane) * 32 + head] + bias, r1 = dtbuf[(size_t)(row0 + 2 * lane + 1) * 32 + head] + bias;
    dt0 = fmaxf(r0, 0.f) + log1pf(__expf(-fabsf(r0))); dt1 = fmaxf(r1, 0.f) + log1pf(__expf(-fabsf(r1)));
    const float a0 = dt0 * Aneg, a1 = dt1 * Aneg;
    float s = a0 + a1;
#pragma unroll
    for (int o = 1; o < 64; o <<= 1) { const float t = __shfl_up(s, o); if (lane >= o) s += t; }
    ac1 = s; ac0 = s - a1;
}

#define XB_TMO      128
#define XB_XCNT(j)  (256  + 64 * (j))
#define XB_XSUB(j)  (1280 + 64 * (j))
#define XB_XGEN(j)  (2304 + 64 * (j))
#define XB_TOP      3328
#define XB_TOPGEN   3392
#define XCD_BAR_WORDS 3456
#define XB_SPIN_CAP (1u << 18)

__device__ __forceinline__ unsigned xb_ld(unsigned* p)              { return __hip_atomic_load(p, __ATOMIC_RELAXED, __HIP_MEMORY_SCOPE_AGENT); }
__device__ __forceinline__ unsigned xb_add(unsigned* p, unsigned v) { return __hip_atomic_fetch_add(p, v, __ATOMIC_RELAXED, __HIP_MEMORY_SCOPE_AGENT); }
__device__ __forceinline__ unsigned xb_xcc_id() { return (unsigned)__builtin_amdgcn_s_getreg((3 << 11) | 20) & 0xFu; }
#define XB_SPIN(cond, bar) do { unsigned _sp = 0; while (cond) { __builtin_amdgcn_s_sleep(1); \
    if ((++_sp & 255u) == 0u) { if (xb_ld(&(bar)[XB_TMO])) break; if (_sp > XB_SPIN_CAP) { atomicAdd(&(bar)[XB_TMO], 1u); break; } } } } while (0)

struct XcdBarrier {
    unsigned* bar; unsigned x;
    volatile LAS unsigned* st;
};

__device__ __forceinline__ XcdBarrier xcd_barrier_post(unsigned* bar, volatile LAS unsigned* st) {
    XcdBarrier b; b.bar = bar; b.x = xb_xcc_id(); b.st = st;
    if (threadIdx.x == 0) (void)xb_add(&bar[XB_XCNT(b.x)], 1u);
    return b;
}
__device__ __forceinline__ void xcd_barrier_complete(unsigned* bar, unsigned x, unsigned& nloc, unsigned& nx) {
    const unsigned G = gridDim.x * gridDim.y * gridDim.z;
    unsigned sum, cnt, mine, sp = 0u;
    for (;;) {
        sum = 0u; cnt = 0u; mine = 0u;
#pragma unroll
        for (unsigned j = 0; j < 16; ++j) { const unsigned c = xb_ld(&bar[XB_XCNT(j)]); sum += c; cnt += (c > 0u) ? 1u : 0u; mine = (j == x) ? c : mine; }
        if (sum == G) break;
        __builtin_amdgcn_s_sleep(1);
        if ((++sp & 255u) == 0u) { if (xb_ld(&bar[XB_TMO])) break; if (sp > XB_SPIN_CAP) { atomicAdd(&bar[XB_TMO], 1u); break; } }
    }
    nloc = mine > 0u ? mine : 1u; nx = cnt > 0u ? cnt : 1u;
}

__device__ __forceinline__ void xcd_barrier(const XcdBarrier& b) {
    asm volatile("s_waitcnt vmcnt(0)" ::: "memory");
    __syncthreads();
    if (threadIdx.x == 0) {
        unsigned* bar = b.bar;
        __builtin_amdgcn_s_waitcnt(0);
        unsigned nloc = b.st[0], nx = b.st[1];
        if (nloc == 0u) { xcd_barrier_complete(bar, b.x, nloc, nx); b.st[0] = nloc; b.st[1] = nx; }
        const unsigned old = xb_add(&bar[XB_XSUB(b.x)], 1u);
        const unsigned gen = old / nloc;
        if (old + 1u == (gen + 1u) * nloc) {
            __builtin_amdgcn_fence(__ATOMIC_RELEASE, "agent");
            asm volatile("s_waitcnt vmcnt(0)" ::: "memory");
            const unsigned og = xb_add(&bar[XB_TOP], 1u);
            const unsigned tg = og / nx;
            if (og + 1u == (tg + 1u) * nx) xb_add(&bar[XB_TOPGEN], 1u);
            else XB_SPIN(xb_ld(&bar[XB_TOPGEN]) == tg, bar);
            __builtin_amdgcn_fence(__ATOMIC_ACQUIRE, "agent");
            xb_add(&bar[XB_XGEN(b.x)], 1u);
            asm volatile("s_waitcnt vmcnt(0)" ::: "memory");
        } else {
            XB_SPIN(xb_ld(&bar[XB_XGEN(b.x)]) == gen, bar);
            __builtin_amdgcn_fence(__ATOMIC_ACQUIRE, "agent");
            asm volatile("s_waitcnt vmcnt(0)" ::: "memory");
        }
    }
    __syncthreads();
}

constexpr int AT_QS = 0, AT_KS = 18432, AT_VT = 55296, AT_PS = 91136, AT_END = AT_PS + 8 * 16 * 336;
static_assert(AT_END <= 147456, "attention LDS");
__device__ __forceinline__ void attn_unit(LAS unsigned char* lds, bf16* P, int blk, int h, float sink, int tid_in) {
    int tid = tid_in; asm volatile("" : "+v"(tid));
    const int lane = tid & 63, w = __builtin_amdgcn_readfirstlane(tid >> 6), fr = lane & 15, kg = lane >> 4;
    const int row0 = blk * 128, g = h >> 2;
#pragma unroll
    for (int i = 0; i < 2; ++i) { const int idx = tid + 512 * i, r = idx >> 3, ch = idx & 7;
        const u32x4 v = *(const u32x4*)(P + (size_t)(row0 + r) * LDP + PC_Q + h * 64 + ch * 8); *(LAS u32x4*)(lds + AT_QS + r * 144 + ch * 16) = v; }
#pragma unroll
    for (int i = 0; i < 4; ++i) { const int idx = tid + 512 * i, kj = idx >> 3, ch = idx & 7; const int srow = (blk > 0) ? row0 - 128 + kj : row0 + (kj & 127);
        const u32x4 v = *(const u32x4*)(P + (size_t)srow * LDP + PC_K + g * 64 + ch * 8); *(LAS u32x4*)(lds + AT_KS + kj * 144 + ch * 16) = v; }
#pragma unroll
    for (int i = 0; i < 4; ++i) { const int idx = tid + 512 * i, kj = idx & 255, ch = idx >> 8; const int srow = (blk > 0) ? row0 - 128 + kj : row0 + (kj & 127);
        const u32x4 v = *(const u32x4*)(P + (size_t)srow * LDP + PC_V + g * 64 + ch * 8);
        LAS unsigned short* d = (LAS unsigned short*)(lds + AT_VT + (ch * 8) * 560 + kj * 2);
        d[0 * 280] = (unsigned short)(v.x & 0xffffu); d[1 * 280] = (unsigned short)(v.x >> 16); d[2 * 280] = (unsigned short)(v.y & 0xffffu); d[3 * 280] = (unsigned short)(v.y >> 16);
        d[4 * 280] = (unsigned short)(v.z & 0xffffu); d[5 * 280] = (unsigned short)(v.z >> 16); d[6 * 280] = (unsigned short)(v.w & 0xffffu); d[7 * 280] = (unsigned short)(v.w >> 16); }
    for (int idx = tid; idx < 64 * 12; idx += 512) { const int d = idx / 12, wv = idx % 12; *(LAS unsigned*)(lds + AT_VT + d * 560 + 512 + wv * 4) = 0u; }
    { const int row = lane >> 2, part = lane & 3; *(LAS u32x2*)(lds + AT_PS + w * 5376 + row * 336 + 288 + part * 8) = (u32x2){0u, 0u}; }
    __syncthreads();
    bf16x8 qf[2];
#pragma unroll
    for (int ks = 0; ks < 2; ++ks) qf[ks] = *(const LAS bf16x8*)(lds + AT_QS + (16 * w + fr) * 144 + (32 * ks + 8 * kg) * 2);
    f32x4 s[9];
#pragma unroll
    for (int ti = 0; ti < 9; ++ti) { const int t = w + ti; f32x4 acc = {0.f, 0.f, 0.f, 0.f};
#pragma unroll
        for (int ks = 0; ks < 2; ++ks) { const bf16x8 kf = *(const LAS bf16x8*)(lds + AT_KS + (16 * t + fr) * 144 + (32 * ks + 8 * kg) * 2); acc = MFMA16(kf, qf[ks], acc); }
        s[ti] = acc; }
    const int qi = 128 + 16 * w + fr; float mx = sink;
#pragma unroll
    for (int ti = 0; ti < 9; ++ti)
#pragma unroll
        for (int j = 0; j < 4; ++j) { const int kj = 16 * (w + ti) + 4 * kg + j, d = qi - kj; const bool valid = (d >= 0) && (d < 128) && (blk > 0 || kj >= 128);
            const float v = valid ? s[ti][j] * 0.125f : -INFINITY; s[ti][j] = v; mx = fmaxf(mx, v); }
    mx = fmaxf(mx, __shfl_xor(mx, 16)); mx = fmaxf(mx, __shfl_xor(mx, 32));
    float sum = 0.f;
#pragma unroll
    for (int ti = 0; ti < 9; ++ti) {
#pragma unroll
        for (int j = 0; j < 4; ++j) { const float p = __expf(s[ti][j] - mx); s[ti][j] = p; sum += p; }
        u32x2 pw; pw.x = cvtpk(s[ti][0], s[ti][1]); pw.y = cvtpk(s[ti][2], s[ti][3]);
        *(LAS u32x2*)(lds + AT_PS + w * 5376 + fr * 336 + (16 * ti + 4 * kg) * 2) = pw; }
    sum += __shfl_xor(sum, 16); sum += __shfl_xor(sum, 32);
    const float inv = 1.0f / (sum + __expf(sink - mx));
    LDS_WAIT(); asm volatile("" ::: "memory");
    f32x4 o[4];
#pragma unroll
    for (int dt = 0; dt < 4; ++dt) o[dt] = (f32x4){0.f, 0.f, 0.f, 0.f};
#pragma unroll
    for (int ks = 0; ks < 5; ++ks) { const bf16x8 pf = *(const LAS bf16x8*)(lds + AT_PS + w * 5376 + fr * 336 + (32 * ks + 8 * kg) * 2);
#pragma unroll
        for (int dt = 0; dt < 4; ++dt) { const bf16x8 vf = *(const LAS bf16x8*)(lds + AT_VT + (16 * dt + fr) * 560 + (16 * w + 32 * ks + 8 * kg) * 2); o[dt] = MFMA16(vf, pf, o[dt]); } }
    bf16* orow = P + (size_t)(row0 + 16 * w + fr) * LDP + PC_Q + h * 64 + 4 * kg;
#pragma unroll
    for (int dt = 0; dt < 4; ++dt) { u32x2 ow; ow.x = cvtpk(o[dt][0] * inv, o[dt][1] * inv); ow.y = cvtpk(o[dt][2] * inv, o[dt][3] * inv); *(u32x2*)(orow + 16 * dt) = ow; }
    __syncthreads();
}

constexpr int S1_BT = 0, S1_XW = 34816, S1_SW = 104448;
__device__ __forceinline__ void s1_unit(LAS unsigned char* lds, const bf16* P, const float* dtbuf, float* dec, bf16* states, int c, int g,
                                        const float* conv_w, const float* conv_b, const float* dt_bias, const float* a_log, int tid_in) {
    int tid = tid_in; asm volatile("" : "+v"(tid));
    const int lane = tid & 63, w = __builtin_amdgcn_readfirstlane(tid >> 6), fr = lane & 15, kg = lane >> 4;
    const int row0 = c * 128;
    { const int hh = 8 * g + w; const float Aneg = -__expf(a_log[hh]); float dt0, dt1, ac0, ac1;
      chunk_decay(dtbuf, row0, hh, dt_bias[hh], Aneg, lane, dt0, dt1, ac0, ac1);
      const float tot = __shfl(ac1, 63);
      LAS float* sw = (LAS float*)(lds + S1_SW) + w * 128;
      sw[2 * lane] = __expf(tot - ac0) * dt0; sw[2 * lane + 1] = __expf(tot - ac1) * dt1;
      if (lane == 63) dec[c * 32 + hh] = __expf(tot); }
    __syncthreads();
    if (tid < 256) { const int lr = tid & 15, cg = tid >> 4; conv_tile8<true>(lds + S1_BT, P, row0, 2048 + g * 128 + cg * 8, cg, lr, conv_w, conv_b, nullptr); }
#pragma unroll 1
    for (int half = 0; half < 2; ++half) {
        if (half) __syncthreads();
        { const int lr = tid & 15, cg = tid >> 4; conv_tile8<true>(lds + S1_XW, P, row0, g * 512 + half * 256 + cg * 8, cg, lr, conv_w, conv_b, (const LAS float*)(lds + S1_SW) + (half * 4 + (cg >> 3)) * 128); }
        __syncthreads();
        const int hl = w >> 1, ph = w & 1;
        f32x4 acc[2][8];
#pragma unroll
        for (int pt = 0; pt < 2; ++pt)
#pragma unroll
            for (int nt = 0; nt < 8; ++nt) acc[pt][nt] = (f32x4){0.f, 0.f, 0.f, 0.f};
#pragma unroll
        for (int ks = 0; ks < 4; ++ks) { bf16x8 xf[2];
#pragma unroll
            for (int pt = 0; pt < 2; ++pt) xf[pt] = *(const LAS bf16x8*)(lds + S1_XW + (hl * 64 + ph * 32 + 16 * pt + fr) * 272 + (32 * ks + 8 * kg) * 2);
#pragma unroll
            for (int nt = 0; nt < 8; ++nt) { const bf16x8 bfr = *(const LAS bf16x8*)(lds + S1_BT + (16 * nt + fr) * 272 + (32 * ks + 8 * kg) * 2);
#pragma unroll
                for (int pt = 0; pt < 2; ++pt) acc[pt][nt] = MFMA16(bfr, xf[pt], acc[pt][nt]); } }
        const int hh = 8 * g + half * 4 + hl;
#pragma unroll
        for (int pt = 0; pt < 2; ++pt) { bf16* sp = states + ((size_t)(c * 32 + hh) * 64 + ph * 32 + 16 * pt + fr) * 128 + 4 * kg;
#pragma unroll
            for (int nt = 0; nt < 8; ++nt) { u32x2 ow; ow.x = cvtpk(acc[pt][nt][0], acc[pt][nt][1]); ow.y = cvtpk(acc[pt][nt][2], acc[pt][nt][3]); *(u32x2*)(sp + 16 * nt) = ow; } }
    }
    __syncthreads();
}
__device__ __forceinline__ void scan_phase(bf16* states, const float* dec, int gtid, int nthr) {
    for (int e = gtid; e < 131072; e += nthr) { const int head = e >> 12; unsigned* p = (unsigned*)states + (size_t)head * 4096 + (e & 4095);
        float h0 = 0.f, h1 = 0.f;
#pragma unroll 8
        for (int c = 0; c < 64; ++c) { const float d = dec[c * 32 + head]; const unsigned v = p[(size_t)c * 131072]; p[(size_t)c * 131072] = cvtpk(h0, h1); h0 = d * h0 + bflo(v); h1 = d * h1 + bfhi(v); } }
}
constexpr int S3_CS = 0, S3_R = 34816, S3_AC = 104448, S3_DT = 108544;
__device__ __forceinline__ void s3_unit(LAS unsigned char* lds, bf16* P, const float* dtbuf, const bf16* states, int c, int g,
                                        const float* conv_w, const float* conv_b, const float* dt_bias, const float* a_log, const float* d_skip, const float* norm_w, int tid_in) {
    int tid = tid_in; asm volatile("" : "+v"(tid));
    const int lane = tid & 63, w = __builtin_amdgcn_readfirstlane(tid >> 6), fr = lane & 15, kg = lane >> 4;
    const int row0 = c * 128;
    { const int hh = 8 * g + w; const float Aneg = -__expf(a_log[hh]); float dt0, dt1, ac0, ac1;
      chunk_decay(dtbuf, row0, hh, dt_bias[hh], Aneg, lane, dt0, dt1, ac0, ac1);
      LAS float* ac = (LAS float*)(lds + S3_AC) + w * 128; LAS float* dv = (LAS float*)(lds + S3_DT) + w * 128;
      ac[2 * lane] = ac0; ac[2 * lane + 1] = ac1; dv[2 * lane] = dt0; dv[2 * lane + 1] = dt1; }
    { const int which = tid >> 8, t2 = tid & 255, cg = t2 & 15, lr = t2 >> 4;
      conv_tile8<false>(lds + (which ? S3_R : S3_CS), P, row0, (which ? 2048 : 2560) + g * 128 + cg * 8, cg, lr, conv_w, conv_b, nullptr); }
    __syncthreads();
    f32x4 cb[8];
    { bf16x8 cf[4];
#pragma unroll
    for (int ks = 0; ks < 4; ++ks) cf[ks] = *(const LAS bf16x8*)(lds + S3_CS + (16 * w + fr) * 272 + (32 * ks + 8 * kg) * 2);
#pragma unroll
    for (int ts = 0; ts < 8; ++ts) { f32x4 acc = {0.f, 0.f, 0.f, 0.f};
        if (ts <= w) {
#pragma unroll
            for (int ks = 0; ks < 4; ++ks) { const bf16x8 bfr = *(const LAS bf16x8*)(lds + S3_R + (16 * ts + fr) * 272 + (32 * ks + 8 * kg) * 2); acc = MFMA16(bfr, cf[ks], acc); } }
        cb[ts] = acc; } }
    asm volatile("" ::: "memory");
    float ssq[4] = {0.f, 0.f, 0.f, 0.f};
    const int lme = 16 * w + fr;
#pragma unroll 1
    for (int hidx = 0; hidx < 8; ++hidx) {
        if ((hidx & 3) == 0) {
            __syncthreads();
            { const int half = hidx >> 2, lr = tid & 15, cg = tid >> 4; conv_tile8<true>(lds + S3_R, P, row0, g * 512 + half * 256 + cg * 8, cg, lr, conv_w, conv_b, nullptr); }
            __syncthreads();
        }
        const int hl = hidx & 3, hh = 8 * g + hidx;
        const LAS float* ac = (const LAS float*)(lds + S3_AC) + hidx * 128; const LAS float* dv = (const LAS float*)(lds + S3_DT) + hidx * 128;
        const float acl = ac[lme];
        f32x4 accD[4], accO[4];
#pragma unroll
        for (int pt = 0; pt < 4; ++pt) { accD[pt] = (f32x4){0.f, 0.f, 0.f, 0.f}; accO[pt] = (f32x4){0.f, 0.f, 0.f, 0.f}; }
#pragma unroll
        for (int ks = 0; ks < 4; ++ks) {
            if (2 * ks <= w) { float mv[8];
#pragma unroll
                for (int tsub = 0; tsub < 2; ++tsub) { const int ts = 2 * ks + tsub; const f32x4 as = *(const LAS f32x4*)(ac + 16 * ts + 4 * kg), ds = *(const LAS f32x4*)(dv + 16 * ts + 4 * kg);
#pragma unroll
                    for (int j = 0; j < 4; ++j) { const int sidx = 16 * ts + 4 * kg + j; mv[4 * tsub + j] = (sidx <= lme) ? cb[ts][j] * __expf(acl - as[j]) * ds[j] : 0.f; } }
                u32x4 mw; mw.x = cvtpk(mv[0], mv[1]); mw.y = cvtpk(mv[2], mv[3]); mw.z = cvtpk(mv[4], mv[5]); mw.w = cvtpk(mv[6], mv[7]);
                const bf16x8 mf = __builtin_bit_cast(bf16x8, mw);
#pragma unroll
                for (int pt = 0; pt < 4; ++pt) { const int chan = hl * 64 + 16 * pt + fr;
                    const u32x2 lo = *(const LAS u32x2*)(lds + S3_R + chan * 272 + (32 * ks + 4 * kg) * 2), hi = *(const LAS u32x2*)(lds + S3_R + chan * 272 + (32 * ks + 16 + 4 * kg) * 2);
                    const u32x4 xw = {lo.x, lo.y, hi.x, hi.y}; accD[pt] = MFMA16(mf, __builtin_bit_cast(bf16x8, xw), accD[pt]); } } }
        { bf16x8 cf2[4];
#pragma unroll
          for (int ks = 0; ks < 4; ++ks) cf2[ks] = *(const LAS bf16x8*)(lds + S3_CS + (16 * w + fr) * 272 + (32 * ks + 8 * kg) * 2);
#pragma unroll
        for (int pt = 0; pt < 4; ++pt) { const bf16* pp = states + ((size_t)(c * 32 + hh) * 64 + 16 * pt + fr) * 128 + 8 * kg;
#pragma unroll
            for (int ks = 0; ks < 4; ++ks) { const bf16x8 pf = *(const bf16x8*)(pp + 32 * ks); accO[pt] = MFMA16(cf2[ks], pf, accO[pt]); }
            asm volatile("" ::: "memory"); } }
        const f32x4 al = *(const LAS f32x4*)(ac + 16 * w + 4 * kg); f32x4 ea;
#pragma unroll
        for (int j = 0; j < 4; ++j) ea[j] = __expf(al[j]);
        const float Dh = d_skip[hh];
#pragma unroll
        for (int pt = 0; pt < 4; ++pt) { const u32x2 xv = *(const LAS u32x2*)(lds + S3_R + (hl * 64 + 16 * pt + fr) * 272 + (16 * w + 4 * kg) * 2);
            const float xs[4] = {bflo(xv.x), bfhi(xv.x), bflo(xv.y), bfhi(xv.y)};
            bf16* zp = P + (size_t)(row0 + 16 * w + 4 * kg) * LDP + PC_Z + hh * 64 + 16 * pt + fr;
#pragma unroll
            for (int j = 0; j < 4; ++j) { const float y = accD[pt][j] + ea[j] * accO[pt][j] + Dh * xs[j]; const float z = __uint_as_float((unsigned)zp[(size_t)j * LDP] << 16);
                const unsigned ub = cvtpk(y * siluf_(z), 0.f) & 0xffffu; const float ur = __uint_as_float(ub << 16); ssq[j] += ur * ur; zp[(size_t)j * LDP] = (bf16)ub; } }
    }
    float rs[4];
#pragma unroll
    for (int j = 0; j < 4; ++j) { float v = ssq[j]; v += __shfl_xor(v, 1); v += __shfl_xor(v, 2); v += __shfl_xor(v, 4); v += __shfl_xor(v, 8); rs[j] = 1.0f / sqrtf(v * (1.0f / 512.0f) + RMS_EPS); }
#pragma unroll 1
    for (int hidx = 0; hidx < 8; ++hidx)
#pragma unroll
        for (int pt = 0; pt < 4; ++pt) { const int col = (8 * g + hidx) * 64 + 16 * pt + fr; const float nw = norm_w[col];
            bf16* up = P + (size_t)(row0 + 16 * w + 4 * kg) * LDP + PC_Z + col;
#pragma unroll
            for (int j = 0; j < 4; ++j) { const float u = __uint_as_float((unsigned)up[(size_t)j * LDP] << 16); up[(size_t)j * LDP] = (bf16)(cvtpk(u * rs[j] * nw, 0.f) & 0xffffu); } }
    __syncthreads();
}
typedef __attribute__((address_space(4))) const char* kptr_t;
typedef void* vp_t; typedef __attribute__((address_space(4))) const vp_t* kpp_t;
#define KARG_PTR(off) ({ kptr_t kp_ = (kptr_t)__builtin_amdgcn_kernarg_segment_ptr(); asm volatile("" : "+s"(kp_)); *(kpp_t)(kp_ + (off)); })
#define IN(i) ((const float*)KARG_PTR(8 * (i)))
#define OUTP ((float*)KARG_PTR(192))
#define WSP ((unsigned char*)KARG_PTR(200))
#define Wgu ((bf16*)(WSP + WS_WGU))
#define Wd ((bf16*)(WSP + WS_WD))
#define Win ((bf16*)(WSP + WS_WIN))
#define Wcat ((bf16*)(WSP + WS_WCAT))
#define Wout ((bf16*)(WSP + WS_WOUT))
#define x1f ((float*)(WSP + WS_X1F))
#define big ((bf16*)(WSP + WS_BIG))
#define dtbuf ((float*)(WSP + WS_DT))
#define dec ((float*)(WSP + WS_DEC))
#define xb ((bf16*)((unsigned char*)OUTP + DO_XB))
#define states ((bf16*)((unsigned char*)OUTP + DO_ST))
struct Args { const float* in[24]; float* out; unsigned char* ws; };
__global__ void __launch_bounds__(NTHR, 2) mega_fwd(Args a) {
    extern __shared__ __attribute__((aligned(16))) unsigned char lds_raw[];
    LAS unsigned char* lds = (LAS unsigned char*)lds_raw;
    cg::grid_group grid = cg::this_grid();
    const int G = gridDim.x, bid = blockIdx.x, NGW = G * NWAVES, nthr = G * NTHR;
#define TID_FRESH() ({ int t_ = threadIdx.x; asm volatile("" : "+v"(t_)); t_; })
#define PHASE_IDS const int tid = TID_FRESH(); const int lane = tid & 63, wave = __builtin_amdgcn_readfirstlane(tid >> 6), gw = bid * NWAVES + wave, gtid = bid * NTHR + tid; (void)lane; (void)gw; (void)gtid; LAS float* scr = (LAS float*)(lds + wave * 16384); (void)scr;
    volatile LAS unsigned* MISC = (volatile LAS unsigned*)(lds + LDS_BYTES - 64);
    if (threadIdx.x < 16) MISC[threadIdx.x] = 0u;
    __syncthreads();
    (void)xcd_barrier_post((unsigned*)(WSP + WS_CTL), MISC + 8);
#define GRID_BAR() do { XcdBarrier b_; b_.bar = (unsigned*)(WSP + WS_CTL); b_.x = xb_xcc_id(); b_.st = (volatile LAS unsigned*)(lds + LDS_BYTES - 64) + 8; xcd_barrier(b_); } while (0)

    { PHASE_IDS
    ffn_weight_items(IN(1), IN(2), IN(3), Wgu, Wd, scr, gw, NGW, lane);
    for (int it = gw; it < 16 * 273; it += NGW) { const int kb = it / 273, nb = it % 273, n0 = nb * 32; tr_item(IN(6), 8736, kb * 64, n0, Win, 1024, map_in(n0), kb * 64, scr, lane); }
    for (int it = gw; it < 512 + 1024 + 512; it += NGW) { int r = it;
        if (r < 512) { tr_item(IN(14), 1024, (r >> 5) * 64, (r & 31) * 32, Wcat, 1024, (r & 31) * 32, (r >> 5) * 64, scr, lane); continue; } r -= 512;
        if (r < 1024) { tr_item(IN(15), 1024, (r >> 5) * 64, (r & 31) * 32, Wcat + (size_t)1024 * 1024, 2048, (r & 31) * 32, (r >> 5) * 64, scr, lane); continue; } r -= 1024;
        tr_item(IN(16), 1024, (r >> 5) * 64, (r & 31) * 32, Wout, 1024, (r & 31) * 32, (r >> 5) * 64, scr, lane); }
    for (int i = gtid; i < 224 * 1024 / 8; i += nthr) *((u32x4*)(Win + (size_t)8736 * 1024) + i) = (u32x4){0u, 0u, 0u, 0u};
    { const float* xin = IN(0); bf16* xbo = xb;
    for (int i = gtid; i < M * 1024 / 8; i += nthr) { const f32x4 v0 = *((const f32x4*)xin + 2 * (size_t)i), v1 = *((const f32x4*)xin + 2 * (size_t)i + 1);
        u32x4 o; o.x = cvtpk(v0.x, v0.y); o.y = cvtpk(v0.z, v0.w); o.z = cvtpk(v1.x, v1.y); o.w = cvtpk(v1.z, v1.w); *((u32x4*)xbo + i) = o; } } }
    grid.sync();
#ifndef SKIP_GEMM1
    { pg8::Gemm g{xb, Wgu, M, 2 * DFF, 1024, 1024}; pg8::StaticOrder S; S.init(M, 2 * DFF, G, bid); pg8::EpiSwiGLU E{0, big, DFF};
      pg8::gemm_phase<pg8::EpiSwiGLU, pg8::StaticOrder, true, true>(lds, g, S, E); }
#endif
    GRID_BAR();
#ifndef SKIP_GEMM2
    { pg8::Gemm g{big, Wd, M, 1024, DFF, DFF}; pg8::StaticOrder S; S.init(M, 1024, G, bid); pg8::EpiResid E{0, IN(0), x1f, 1024, ALPHA, 0.5f};
      pg8::gemm_phase<pg8::EpiResid, pg8::StaticOrder, true, true>(lds, g, S, E); }
#endif
    GRID_BAR();
    { PHASE_IDS ln_rows(x1f, x1f, xb, IN(4), IN(5), M, gw, NGW, lane); }
    GRID_BAR();
#pragma unroll 1
    for (int b = 0; b < 2; ++b) {
#ifndef SKIP_GEMM3
        { pg8::Gemm g{xb + (size_t)b * MB * 1024, Win, MB, NPROJ, 1024, 1024}; pg8::StaticOrder S; S.init(MB, NPROJ, G, bid); pg8::EpiInProj E{0, big, LDP, dtbuf};
          pg8::gemm_phase<pg8::EpiInProj, pg8::StaticOrder, true, true>(lds, g, S, E); }
#endif
        GRID_BAR();
#ifndef SKIP_S1
        for (int u = bid; u < 256; u += G) s1_unit(lds, big, dtbuf, dec, states, u >> 2, u & 3, IN(7), IN(8), IN(9), IN(10), threadIdx.x);
#endif
#ifndef SKIP_ATTN
        for (int u = bid; u < 1024; u += G) attn_unit(lds, big, u >> 4, u & 15, IN(13)[u & 15], threadIdx.x);
#endif
        GRID_BAR();
        { PHASE_IDS scan_phase(states, dec, gtid, nthr); }
        GRID_BAR();
#ifndef SKIP_S3
        for (int u = bid; u < 256; u += G) s3_unit(lds, big, dtbuf, states, u >> 2, u & 3, IN(7), IN(8), IN(9), IN(10), IN(11), IN(12), threadIdx.x);
#endif
        GRID_BAR();
#ifndef SKIP_G4
        { pg8::Gemm g{big + PC_Q, Wcat, MB, 1024, 1024, LDP}; pg8::StaticOrder S; S.init(MB, 1024, G, bid); pg8::EpiGate<0> E{0, big + PC_GA, LDP, PC_GS - PC_GA};
          pg8::gemm_phase<pg8::EpiGate<0>, pg8::StaticOrder, true, true>(lds, g, S, E); }
        { pg8::Gemm g{big + PC_Z, Wcat + (size_t)1024 * 1024, MB, 1024, 2048, LDP}; pg8::StaticOrder S; S.init(MB, 1024, G, bid); pg8::EpiGate<1> E{0, big + PC_GA, LDP, PC_GS - PC_GA};
          pg8::gemm_phase<pg8::EpiGate<1>, pg8::StaticOrder, true, true>(lds, g, S, E); }
#endif
        GRID_BAR();
#ifndef SKIP_GEMM4
        { float* xr = x1f + (size_t)b * MB * 1024; pg8::Gemm g{big + PC_GA, Wout, MB, 1024, 1024, LDP}; pg8::StaticOrder S; S.init(MB, 1024, G, bid); pg8::EpiResid E{0, xr, xr, 1024, ALPHA, 1.0f};
          pg8::gemm_phase<pg8::EpiResid, pg8::StaticOrder, true, true>(lds, g, S, E); }
#endif
        GRID_BAR();
    }
    { PHASE_IDS ffn_weight_items(IN(19), IN(20), IN(21), Wgu, Wd, scr, gw, NGW, lane);
      ln_rows(x1f, x1f, xb, IN(17), IN(18), M, gw, NGW, lane); }
    GRID_BAR();
#ifndef SKIP_GEMM5
    { pg8::Gemm g{xb, Wgu, M, 2 * DFF, 1024, 1024}; pg8::StaticOrder S; S.init(M, 2 * DFF, G, bid); pg8::EpiSwiGLU E{0, big, DFF};
      pg8::gemm_phase<pg8::EpiSwiGLU, pg8::StaticOrder, true, true>(lds, g, S, E); }
#endif
    GRID_BAR();
#ifndef SKIP_GEMM6
    { pg8::Gemm g{big, Wd, M, 1024, DFF, DFF}; pg8::StaticOrder S; S.init(M, 1024, G, bid); pg8::EpiResid E{0, x1f, OUTP, 1024, ALPHA, 0.5f};
      pg8::gemm_phase<pg8::EpiResid, pg8::StaticOrder, true, true>(lds, g, S, E); }
#endif
    GRID_BAR();
    { PHASE_IDS ln_rows(OUTP, OUTP, nullptr, IN(22), IN(23), M, gw, NGW, lane); }
}

#undef Wgu
#undef Wd
#undef Win
#undef Wcat
#undef Wout
#undef x1f
#undef big
#undef dtbuf
#undef dec
#undef xb
#undef states
extern "C" void kernel_launch(void* const* d_in, const int* in_sizes, int n_in, void* d_out, int out_size, void* d_ws, size_t ws_size, hipStream_t stream) {
    static int grid = 0;
    if (grid == 0) {
        if (n_in != 24 || out_size != M * 1024 || ws_size < WS_END) { fprintf(stderr, "kernel_launch: unexpected shapes (n_in %d out %d ws %zu)\n", n_in, out_size, ws_size); grid = -1; return; }
        int dev = 0, cus = 0, per_cu = 0;
        (void)hipGetDevice(&dev); (void)hipDeviceGetAttribute(&cus, hipDeviceAttributeMultiprocessorCount, dev);
        (void)hipFuncSetAttribute((const void*)mega_fwd, hipFuncAttributeMaxDynamicSharedMemorySize, LDS_BYTES);
        (void)hipOccupancyMaxActiveBlocksPerMultiprocessor(&per_cu, (const void*)mega_fwd, NTHR, LDS_BYTES);
        if (per_cu < 1) per_cu = 1;
        grid = cus * per_cu; if (grid > 256) grid = 256;
        (void)hipGetLastError();
    }
    if (grid < 0) return;
    if (hipMemsetAsync((char*)d_ws + WS_CTL, 0, 65536, stream) != hipSuccess) { fprintf(stderr, "memset failed\n"); return; }
    Args a{};
    for (int i = 0; i < 24; ++i) a.in[i] = (const float*)d_in[i];
    a.out = (float*)d_out; a.ws = (unsigned char*)d_ws;
    void* args[] = {&a};
    hipError_t e = hipLaunchCooperativeKernel((const void*)mega_fwd, dim3(grid), dim3(NTHR), args, LDS_BYTES, stream);
    if (e != hipSuccess) fprintf(stderr, "cooperative launch failed: %s (grid %d)\n", hipGetErrorString(e), grid);
}
```

```cpp
#include <hip/hip_runtime.h>
#include <hip/hip_cooperative_groups.h>
#include <cstdio>
#include <cstdint>
namespace cg = cooperative_groups;
namespace pg8 {
#define PG8_LAS __attribute__((address_space(3)))
typedef unsigned short bf16_t;
typedef short bf16x8 __attribute__((ext_vector_type(8)));
typedef float f32x4 __attribute__((ext_vector_type(4)));
typedef unsigned u32x4 __attribute__((ext_vector_type(4)));
constexpr int BM = 256, BK = 64, HALF = 128, HTB = HALF * BK * 2  , STAGE_BYTES = 8 * HTB, NXCD = 8, WGM = 8;

__host__ __device__ __forceinline__ int lds_byte(int r, int c) { const int st = (r >> 4) * 2 + (c >> 5), rr = r & 15, cc = c & 31, ob = rr * 64 + cc * 2; return st * 1024 + (ob ^ (((ob >> 9) & 1) << 5)); }
__host__ __device__ __forceinline__ void stage_rc(int b, int& R, int& C) { const int st = b / 1024, sb = b % 1024, swz = sb ^ (((sb >> 9) & 1) << 5); R = (st >> 1) * 16 + swz / 64; C = (st & 1) * 32 + (swz % 64) / 2; }
__host__ __device__ __forceinline__ int perm32(int rho) { const int n = rho >> 4, i = rho & 15; return 8 * (i >> 2) + 4 * n + (i & 3); }

struct Unit { int pm, pn; };
struct Gemm { const bf16_t* A; const bf16_t* Bt; int M, N, K, lda; };

struct StaticOrder {
    int nM, nN, nwg, G, c;
    __host__ __device__ void init(int M, int N, int G_, int c_) { nM = M / BM; nN = N / BM; nwg = nM * nN; G = G_; c = c_; }
    __host__ __device__ bool next(int i, Unit& u) const {
        const long L = (long)i * G + c; if (L >= nwg) return false;
        int wgid = (int)L; { const int q = nwg / NXCD, r = nwg % NXCD, xcd = wgid % NXCD, off = wgid / NXCD; wgid = (xcd < r ? xcd * (q + 1) : r * (q + 1) + (xcd - r) * q) + off; }
        const int nig = WGM * nN, gid = wgid / nig, fm = gid * WGM, gsz = (nM - fm) < WGM ? (nM - fm) : WGM;
        u.pm = fm + ((wgid % nig) % gsz); u.pn = (wgid % nig) / gsz; return true;
    }
    __device__ __forceinline__ void a_ready(const Unit&) const {}
    __device__ __forceinline__ void done(const Unit&) const {}
};

typedef float f32x2_t __attribute__((ext_vector_type(2))); typedef __bf16 bf16x2_t __attribute__((ext_vector_type(2)));
__device__ __forceinline__ unsigned cvtpk(float lo, float hi) { f32x2_t v = {lo, hi}; bf16x2_t b = __builtin_convertvector(v, bf16x2_t); return __builtin_bit_cast(unsigned, b); }
__device__ __forceinline__ float bflo(unsigned w) { return __uint_as_float(w << 16); }
__device__ __forceinline__ float bfhi(unsigned w) { return __uint_as_float(w & 0xffff0000u); }
__device__ __forceinline__ float sigmoidf_(float x) { return __builtin_amdgcn_rcpf(1.0f + __builtin_amdgcn_exp2f(-1.4426950408889634f * x)); }
__device__ __forceinline__ float siluf_(float x) { return x * sigmoidf_(x); }

struct EpiSwiGLU {
    static constexpr bool PERM = true, AFTER_DRAIN = false, HAS_MID = false; int mid_t;
    bf16_t* O; int ldc;
    __device__ __forceinline__ void mid(f32x4 (&)[2][2][4][2], const Unit&, int, int, int, int) const {}
    __device__ __forceinline__ void operator()(const f32x4 (&acc)[2][2][4][2], const Unit& u, int wr, int wc, int fr, int fq) const {
        const int row0 = u.pm * BM + wr * 64 + fr, col0 = u.pn * HALF + wc * 32 + 8 * fq;
#pragma unroll
        for (int ai = 0; ai < 2; ++ai)
#pragma unroll
            for (int m = 0; m < 4; ++m) { bf16_t* rowp = O + (size_t)(row0 + ai * HALF + m * 16) * ldc + col0;
                const f32x4 g0 = acc[ai][0][m][0], g1 = acc[ai][0][m][1], u0 = acc[ai][1][m][0], u1 = acc[ai][1][m][1];
                u32x4 w; w.x = cvtpk(siluf_(g0[0]) * u0[0], siluf_(g0[1]) * u0[1]); w.y = cvtpk(siluf_(g0[2]) * u0[2], siluf_(g0[3]) * u0[3]);
                w.z = cvtpk(siluf_(g1[0]) * u1[0], siluf_(g1[1]) * u1[1]); w.w = cvtpk(siluf_(g1[2]) * u1[2], siluf_(g1[3]) * u1[3]);
                *(u32x4*)rowp = w; }
    }
};
struct EpiResid {
    static constexpr bool PERM = false, AFTER_DRAIN = false, HAS_MID = false; int mid_t;
    const float* res; float* out; int ldc; float alpha, s;
    __device__ __forceinline__ void mid(f32x4 (&)[2][2][4][2], const Unit&, int, int, int, int) const {}
    __device__ __forceinline__ void operator()(const f32x4 (&acc)[2][2][4][2], const Unit& u, int wr, int wc, int fr, int fq) const {
        const int row0 = u.pm * BM + wr * 64 + fr, col0 = u.pn * BM + wc * 32 + 4 * fq;
#pragma unroll
        for (int ai = 0; ai < 2; ++ai)
#pragma unroll
            for (int m = 0; m < 4; ++m) { const size_t off = (size_t)(row0 + ai * HALF + m * 16) * ldc + col0;
#pragma unroll
                for (int bj = 0; bj < 2; ++bj)
#pragma unroll
                    for (int n = 0; n < 2; ++n) { const f32x4 r = *(const f32x4*)(res + off + bj * HALF + n * 16); *(f32x4*)(out + off + bj * HALF + n * 16) = r * alpha + acc[ai][bj][m][n] * s; } }
    }
};
struct EpiInProj {
    static constexpr bool PERM = true, AFTER_DRAIN = false, HAS_MID = false; int mid_t;
    bf16_t* O; int ldc; float* dt;
    __device__ __forceinline__ void mid(f32x4 (&)[2][2][4][2], const Unit&, int, int, int, int) const {}
    __device__ __forceinline__ void operator()(const f32x4 (&acc)[2][2][4][2], const Unit& u, int wr, int wc, int fr, int fq) const {
        const int row0 = u.pm * BM + wr * 64 + fr;
        if (u.pn == 34) {
            if (wc == 0) {
#pragma unroll
                for (int ai = 0; ai < 2; ++ai)
#pragma unroll
                    for (int m = 0; m < 4; ++m) { float* p = dt + (size_t)(row0 + ai * HALF + m * 16) * 32 + 8 * fq; *(f32x4*)p = acc[ai][0][m][0]; *(f32x4*)(p + 4) = acc[ai][0][m][1]; }
            }
            return;
        }
        const bool gate = u.pn >= 26; const int col0 = u.pn * BM + wc * 32 + 8 * fq;
#pragma unroll
        for (int ai = 0; ai < 2; ++ai)
#pragma unroll
            for (int m = 0; m < 4; ++m) { bf16_t* rowp = O + (size_t)(row0 + ai * HALF + m * 16) * ldc + col0;
#pragma unroll
                for (int bj = 0; bj < 2; ++bj) { f32x4 v0 = acc[ai][bj][m][0], v1 = acc[ai][bj][m][1];
                    if (gate) {
#pragma unroll
                        for (int i = 0; i < 4; ++i) { v0[i] = sigmoidf_(v0[i]); v1[i] = sigmoidf_(v1[i]); } }
                    u32x4 w; w.x = cvtpk(v0[0], v0[1]); w.y = cvtpk(v0[2], v0[3]); w.z = cvtpk(v1[0], v1[1]); w.w = cvtpk(v1[2], v1[3]);
                    *(u32x4*)(rowp + bj * HALF) = w; } }
    }
};
template <int MODE> struct EpiGate {
    static constexpr bool PERM = true, AFTER_DRAIN = false, HAS_MID = false; int mid_t;
    bf16_t* G; int ldc; int gsoff; bf16_t* O2; int ldo;
    __device__ __forceinline__ void mid(f32x4 (&)[2][2][4][2], const Unit&, int, int, int, int) const {}
    __device__ __forceinline__ void operator()(const f32x4 (&acc)[2][2][4][2], const Unit& u, int wr, int wc, int fr, int fq) const {
        const int row0 = u.pm * BM + wr * 64 + fr, col0 = u.pn * BM + wc * 32 + 8 * fq;
#pragma unroll
        for (int ai = 0; ai < 2; ++ai)
#pragma unroll
            for (int m = 0; m < 4; ++m) { bf16_t* rowp = G + (size_t)(row0 + ai * HALF + m * 16) * ldc + col0; bf16_t* orow = (MODE == 0) ? rowp : O2 + (size_t)(row0 + ai * HALF + m * 16) * ldo + col0;
#pragma unroll
                for (int bj = 0; bj < 2; ++bj) { const u32x4 t = *(const u32x4*)(rowp + bj * HALF); const f32x4 v0 = acc[ai][bj][m][0], v1 = acc[ai][bj][m][1]; u32x4 w;
                    if (MODE == 0) { w.x = cvtpk(v0[0] * bflo(t.x), v0[1] * bfhi(t.x)); w.y = cvtpk(v0[2] * bflo(t.y), v0[3] * bfhi(t.y));
                        w.z = cvtpk(v1[0] * bflo(t.z), v1[1] * bfhi(t.z)); w.w = cvtpk(v1[2] * bflo(t.w), v1[3] * bfhi(t.w)); }
                    else { const u32x4 s = *(const u32x4*)(rowp + bj * HALF + gsoff);
                        w.x = cvtpk(bflo(t.x) + v0[0] * bflo(s.x), bfhi(t.x) + v0[1] * bfhi(s.x)); w.y = cvtpk(bflo(t.y) + v0[2] * bflo(s.y), bfhi(t.y) + v0[3] * bfhi(s.y));
                        w.z = cvtpk(bflo(t.z) + v1[0] * bflo(s.z), bfhi(t.z) + v1[1] * bfhi(s.z)); w.w = cvtpk(bflo(t.w) + v1[2] * bflo(s.w), bfhi(t.w) + v1[3] * bfhi(s.w)); }
                    *(u32x4*)(orow + bj * HALF) = w; } }
    }
};
template <class Epi, class Sched, bool ALIGN_EPI = false, bool SP2 = false>
__device__ __forceinline__ void gemm_phase(PG8_LAS unsigned char* lds, const Gemm g, const Sched& S, const Epi& E) {
    int tid_ = threadIdx.x; asm volatile("" : "+v"(tid_)); const int tid = tid_, wid = __builtin_amdgcn_readfirstlane(tid >> 6), lane = tid & 63, wr = wid >> 2, wc = wid & 3, fr = lane & 15, fq = lane >> 4;
    const int K = g.K, nt = K / BK;
    unsigned voffA[2], voffB[2];
#pragma unroll
    for (int i = 0; i < 2; ++i) { int R, C; stage_rc(tid * 16 + i * 8192, R, C); const int Rb = Epi::PERM ? ((R & ~31) + perm32(R & 31)) : R;
        voffA[i] = (unsigned)(R * g.lda + C) * 2u; voffB[i] = (unsigned)(Rb * K + C) * 2u; }
    const size_t kstep = (size_t)(BK * 2);
    const size_t hstepB = (size_t)HALF * K * 2, hstepA = (size_t)HALF * g.lda * 2;
    const size_t tstepA = 2 * hstepA, tstepB = 2 * hstepB;
    const unsigned ldsw = (unsigned)wid * 1024u;
    const int aoff = lds_byte(wr * 64 + fr, fq * 8), boff = lds_byte(wc * 32 + fr, fq * 8);
#define PG8_SA(b, h) (((b) * 2 + (h)) * HTB)
#define PG8_SB(b, h) ((4 + (b) * 2 + (h)) * HTB)
#define PG8_STAGE(bufoff, gbase, voff) do { _Pragma("unroll") for (int _i = 0; _i < 2; ++_i) \
        __builtin_amdgcn_global_load_lds((const unsigned*)((const char*)(gbase) + (voff)[_i]), (PG8_LAS unsigned*)(lds + (bufoff) + ldsw + _i * 8192), 16, 0, 0); } while (0)
#define PG8_LDA(dst, b, h) do { _Pragma("unroll") for (int m = 0; m < 4; ++m) _Pragma("unroll") for (int k = 0; k < 2; ++k) dst[m][k] = *(const PG8_LAS bf16x8*)(lds + PG8_SA(b, h) + aoff + m * 2048 + k * 1024); } while (0)
#define PG8_LDB(dst, b, h) do { _Pragma("unroll") for (int n = 0; n < 2; ++n) _Pragma("unroll") for (int k = 0; k < 2; ++k) dst[n][k] = *(const PG8_LAS bf16x8*)(lds + PG8_SB(b, h) + boff + n * 2048 + k * 1024); } while (0)
#define PG8_MMA(ai, bj, At, Bt) do { __builtin_amdgcn_s_setprio(1); _Pragma("unroll") for (int m = 0; m < 4; ++m) _Pragma("unroll") for (int n = 0; n < 2; ++n) _Pragma("unroll") for (int k = 0; k < 2; ++k) \
        acc[ai][bj][m][n] = __builtin_amdgcn_mfma_f32_16x16x32_bf16(Bt[n][k], At[m][k], acc[ai][bj][m][n], 0, 0, 0); __builtin_amdgcn_s_setprio(0); } while (0)
#define PG8_WAIT_V(n) asm volatile("s_waitcnt vmcnt(" #n ")" ::: "memory")
#define PG8_WAIT_L(n) asm volatile("s_waitcnt lgkmcnt(" #n ")" ::: "memory")
#define PG8_BAR __builtin_amdgcn_s_barrier()
#define PG8_SCHED __builtin_amdgcn_sched_barrier(0)
    Unit cur, nxt; int ui = 0;
    if (!S.next(0, cur)) return;
    f32x4 acc[2][2][4][2];
#pragma unroll
    for (int a = 0; a < 2; ++a)
#pragma unroll
        for (int b = 0; b < 2; ++b)
#pragma unroll
            for (int m = 0; m < 4; ++m)
#pragma unroll
                for (int n = 0; n < 2; ++n) acc[a][b][m][n] = (f32x4){0.f, 0.f, 0.f, 0.f};
    bf16x8 At[4][2], B0[2][2], B1[2][2];
    const char* cA = (const char*)g.A + (size_t)cur.pm * tstepA; const char* cB = (const char*)g.Bt + (size_t)cur.pn * tstepB;
    S.a_ready(cur);
    if constexpr (SP2) {
        PG8_STAGE(PG8_SB(0, 0), cB, voffB); PG8_STAGE(PG8_SB(0, 1), cB + hstepB, voffB); PG8_STAGE(PG8_SA(0, 0), cA, voffA); PG8_STAGE(PG8_SA(0, 1), cA + hstepA, voffA);
        if (wr == 1) PG8_BAR;
        PG8_WAIT_V(2); PG8_BAR;
        PG8_STAGE(PG8_SB(1, 0), cB + kstep, voffB); PG8_STAGE(PG8_SA(1, 0), cA + kstep, voffA); PG8_STAGE(PG8_SB(1, 1), cB + hstepB + kstep, voffB);
        PG8_WAIT_V(6); PG8_BAR;
    } else {
        PG8_STAGE(PG8_SB(0, 0), cB, voffB); PG8_STAGE(PG8_SA(0, 0), cA, voffA); PG8_STAGE(PG8_SB(0, 1), cB + hstepB, voffB); PG8_STAGE(PG8_SA(0, 1), cA + hstepA, voffA);
        if (wr == 1) PG8_BAR;
        PG8_WAIT_V(4); PG8_BAR;
        PG8_STAGE(PG8_SB(1, 0), cB + kstep, voffB); PG8_STAGE(PG8_SA(1, 0), cA + kstep, voffA); PG8_STAGE(PG8_SB(1, 1), cB + hstepB + kstep, voffB);
        PG8_WAIT_V(6); PG8_BAR;
    }
    for (;;) {
        const bool has_next = S.next(ui + 1, nxt);
        const char* nA = has_next ? (const char*)g.A + (size_t)nxt.pm * tstepA : cA; const char* nB = has_next ? (const char*)g.Bt + (size_t)nxt.pn * tstepB : cB;
        for (int t = 0; t < nt; t += 2) {
            if constexpr (Epi::HAS_MID) { if (t == E.mid_t) E.mid(acc, cur, wr, wc, fr, fq); }
            const bool last = (t == nt - 2);
            const char* a1 = cA + (size_t)(t + 1) * kstep;
            const char* a2 = last ? nA : cA + (size_t)(t + 2) * kstep; const char* b2 = last ? nB : cB + (size_t)(t + 2) * kstep;
            const char* a3 = a2 + kstep; const char* b3 = b2 + kstep;
            if (last && has_next) S.a_ready(nxt);
            if constexpr (SP2) {
            PG8_LDB(B0, 0, 0); PG8_LDB(B1, 0, 1); PG8_SCHED; PG8_LDA(At, 0, 0); PG8_STAGE(PG8_SA(1, 1), a1 + hstepA, voffA);
            PG8_WAIT_V(8); PG8_WAIT_L(0); PG8_BAR; PG8_MMA(0, 0, At, B0); PG8_MMA(0, 1, At, B1); PG8_BAR; PG8_SCHED;
            PG8_LDA(At, 0, 1); PG8_STAGE(PG8_SB(0, 0), b2, voffB); PG8_STAGE(PG8_SB(0, 1), b2 + hstepB, voffB); PG8_STAGE(PG8_SA(0, 0), a2, voffA);
            PG8_WAIT_V(8); PG8_WAIT_L(0); PG8_BAR; PG8_MMA(1, 0, At, B0); PG8_MMA(1, 1, At, B1); PG8_BAR; PG8_SCHED;
            PG8_LDB(B0, 1, 0); PG8_LDB(B1, 1, 1); PG8_SCHED; PG8_LDA(At, 1, 0); PG8_STAGE(PG8_SA(0, 1), a2 + hstepA, voffA);
            PG8_WAIT_V(8); PG8_WAIT_L(0); PG8_BAR; PG8_MMA(0, 0, At, B0); PG8_MMA(0, 1, At, B1); PG8_BAR; PG8_SCHED;
            PG8_LDA(At, 1, 1); PG8_STAGE(PG8_SB(1, 0), b3, voffB); PG8_STAGE(PG8_SB(1, 1), b3 + hstepB, voffB); PG8_STAGE(PG8_SA(1, 0), a3, voffA);
            PG8_WAIT_V(8); PG8_WAIT_L(0); PG8_BAR; PG8_MMA(1, 0, At, B0); PG8_MMA(1, 1, At, B1); PG8_BAR; PG8_SCHED;
            } else {
            PG8_LDB(B0, 0, 0); PG8_SCHED; PG8_LDA(At, 0, 0); PG8_STAGE(PG8_SA(1, 1), a1 + hstepA, voffA);
            PG8_WAIT_L(8); PG8_BAR; PG8_WAIT_L(0); PG8_MMA(0, 0, At, B0); PG8_BAR; PG8_SCHED;
            PG8_LDB(B1, 0, 1); PG8_STAGE(PG8_SB(0, 0), b2, voffB);
            PG8_BAR; PG8_WAIT_L(0); PG8_MMA(0, 1, At, B1); PG8_BAR;
            PG8_LDA(At, 0, 1); PG8_STAGE(PG8_SA(0, 0), a2, voffA);
            PG8_BAR; PG8_WAIT_L(0); PG8_MMA(1, 0, At, B0); PG8_BAR; PG8_SCHED;
            PG8_STAGE(PG8_SB(0, 1), b2 + hstepB, voffB);
            PG8_WAIT_V(6); PG8_BAR; PG8_MMA(1, 1, At, B1); PG8_BAR;
            PG8_LDB(B0, 1, 0); PG8_SCHED; PG8_LDA(At, 1, 0); PG8_STAGE(PG8_SA(0, 1), a2 + hstepA, voffA);
            PG8_WAIT_L(8); PG8_BAR; PG8_WAIT_L(0); PG8_MMA(0, 0, At, B0); PG8_BAR; PG8_SCHED;
            PG8_LDB(B1, 1, 1); PG8_STAGE(PG8_SB(1, 0), b3, voffB);
            PG8_BAR; PG8_WAIT_L(0); PG8_MMA(0, 1, At, B1); PG8_BAR;
            PG8_LDA(At, 1, 1); PG8_STAGE(PG8_SA(1, 0), a3, voffA);
            PG8_BAR; PG8_WAIT_L(0); PG8_MMA(1, 0, At, B0); PG8_BAR; PG8_SCHED;
            PG8_STAGE(PG8_SB(1, 1), b3 + hstepB, voffB);
            PG8_WAIT_V(6); PG8_BAR; PG8_MMA(1, 1, At, B1); PG8_BAR;
            }
        }
        if constexpr (ALIGN_EPI) { if (wr == 0) PG8_BAR; }
        if constexpr (!Epi::AFTER_DRAIN) { E(acc, cur, wr, wc, fr, fq); S.done(cur); }
        if (!has_next) break;
#pragma unroll
        for (int a = 0; a < 2; ++a)
#pragma unroll
            for (int b = 0; b < 2; ++b)
#pragma unroll
                for (int m = 0; m < 4; ++m)
#pragma unroll
                    for (int n = 0; n < 2; ++n) acc[a][b][m][n] = (f32x4){0.f, 0.f, 0.f, 0.f};
        cur = nxt; cA = nA; cB = nB; ++ui;
        if constexpr (ALIGN_EPI) { if (wr == 1) PG8_BAR; }
    }
    PG8_WAIT_V(0);
    if constexpr (!ALIGN_EPI) { if (wr == 0) PG8_BAR; }
    PG8_BAR;
    if constexpr (Epi::AFTER_DRAIN) { E.fused(acc, cur, wr, wc, fr, fq, lds, wid, lane); S.done(cur); }
#undef PG8_SA
#undef PG8_SB
#undef PG8_STAGE
#undef PG8_LDA
#undef PG8_LDB
#undef PG8_MMA
#undef PG8_WAIT_V
#undef PG8_WAIT_L
#undef PG8_BAR
#undef PG8_SCHED
}
}

#define LAS __attribute__((address_space(3)))
typedef unsigned short bf16;
typedef float f32x4 __attribute__((ext_vector_type(4)));
typedef short bf16x8 __attribute__((ext_vector_type(8)));
typedef short bf16x4 __attribute__((ext_vector_type(4)));
typedef unsigned u32x4 __attribute__((ext_vector_type(4)));
typedef unsigned u32x2 __attribute__((ext_vector_type(2)));
using pg8::cvtpk; using pg8::bflo; using pg8::bfhi; using pg8::siluf_; using pg8::sigmoidf_;
constexpr int NWAVES = 8, NTHR = 512;
constexpr int M = 16384, MB = 8192, DMODEL = 1024, DFF = 2816;
constexpr int LDP = 8704;
constexpr int PC_Q = 0, PC_Z = 1024, PC_K = 3072, PC_V = 3328, PC_XBC = 3584, PC_GA = 6656, PC_GS = 7680;
constexpr int NPROJ = 8960;
constexpr float LN_EPS = 1e-5f, RMS_EPS = 1e-5f;
constexpr float ALPHA = 1.189207115002721f;
constexpr size_t MiB = 1u << 20;
constexpr size_t WS_CTL = 0, WS_DEC = 512 * 1024, WS_DT = 1 * MiB, WS_WGU = 2 * MiB, WS_WD = 13 * MiB, WS_WIN = 19 * MiB, WS_WCAT = 37 * MiB, WS_WOUT = 43 * MiB, WS_X1F = 45 * MiB, WS_BIG = 109 * MiB, WS_END = 245 * MiB;
constexpr size_t DO_XB = 0, DO_ST = 32 * MiB;
constexpr int LDS_BYTES = 147456;

#define LDS_WAIT() asm volatile("s_waitcnt lgkmcnt(0)" ::: "memory")
#define MFMA16(a, b, c) __builtin_amdgcn_mfma_f32_16x16x32_bf16((a), (b), (c), 0, 0, 0)

__device__ __forceinline__ float wave_sum(float v) {
#pragma unroll
    for (int o = 1; o < 64; o <<= 1) v += __shfl_xor(v, o);
    return v;
}
__device__ __forceinline__ void tr_item(const float* W, int ldw, int k0, int n0, bf16* WT, int ldt, int drow, int dcol, LAS float* scr, int lane) {
#pragma unroll 8
    for (int i = 0; i < 32; ++i) { const int kk = 2 * i + (lane >> 5); scr[kk * 33 + (lane & 31)] = W[(size_t)(k0 + kk) * ldw + n0 + (lane & 31)]; }
    LDS_WAIT(); asm volatile("" ::: "memory");
    const int c = lane & 7;
#pragma unroll
    for (int j = 0; j < 4; ++j) { const int n = (lane >> 3) + 8 * j; const LAS float* s = scr + (8 * c) * 33 + n;
        u32x4 o; o.x = cvtpk(s[0 * 33], s[1 * 33]); o.y = cvtpk(s[2 * 33], s[3 * 33]); o.z = cvtpk(s[4 * 33], s[5 * 33]); o.w = cvtpk(s[6 * 33], s[7 * 33]);
        *(u32x4*)(WT + (size_t)(drow + n) * ldt + dcol + 8 * c) = o; }
    LDS_WAIT(); asm volatile("" ::: "memory");
}
__device__ __forceinline__ int map_in(int n0) {
    if (n0 < 1024) return n0;
    if (n0 < 1280) return PC_K + (n0 - 1024);
    if (n0 < 1536) return PC_V + (n0 - 1280);
    if (n0 < 3584) return PC_Z + (n0 - 1536);
    if (n0 < 6656) return n0;
    if (n0 < 6688) return 8704 + (n0 - 6656);
    if (n0 < 7712) return PC_GA + (n0 - 6688);
    return PC_GS + (n0 - 7712);
}
__device__ __forceinline__ void ffn_weight_items(const float* wg, const float* wu, const float* wd, bf16* Wgu, bf16* Wd, LAS float* scr, int gw, int NGW, int lane) {
    constexpr int I_G = 16 * 88, I_D = 44 * 32;
    for (int it = gw; it < 2 * I_G + I_D; it += NGW) {
        int r = it;
        if (r < 2 * I_G) { const bool up = r >= I_G; if (up) r -= I_G; const int kb = r / 88, nb = r % 88, n0 = nb * 32;
            tr_item(up ? wu : wg, DFF, kb * 64, n0, Wgu, 1024, (n0 >> 7) * 256 + (n0 & 127) + (up ? 128 : 0), kb * 64, scr, lane); continue; }
        r -= 2 * I_G; { const int kb = r / 32, nb = r % 32; tr_item(wd, 1024, kb * 64, nb * 32, Wd, DFF, nb * 32, kb * 64, scr, lane); }
    }
}
__device__ __forceinline__ void ln_rows(const float* src, float* dstf, bf16* dstb, const float* g, const float* b, int nrows, int gw, int NGW, int lane) {
    f32x4 gv[4], bv[4];
#pragma unroll
    for (int j = 0; j < 4; ++j) { gv[j] = *((const f32x4*)g + lane + 64 * j); bv[j] = *((const f32x4*)b + lane + 64 * j); }
    for (int m = gw; m < nrows; m += NGW) {
        const f32x4* xr = (const f32x4*)(src + (size_t)m * 1024) + lane;
        f32x4 v[4]; float s = 0.f;
#pragma unroll
        for (int j = 0; j < 4; ++j) { v[j] = xr[64 * j]; s += (v[j].x + v[j].y) + (v[j].z + v[j].w); }
        const float mean = wave_sum(s) * (1.f / 1024.f); float s2 = 0.f;
#pragma unroll
        for (int j = 0; j < 4; ++j) { v[j] = v[j] - mean; s2 += (v[j].x * v[j].x + v[j].y * v[j].y) + (v[j].z * v[j].z + v[j].w * v[j].w); }
        const float rstd = 1.f / sqrtf(wave_sum(s2) * (1.f / 1024.f) + LN_EPS);
#pragma unroll
        for (int j = 0; j < 4; ++j) { const f32x4 y = v[j] * rstd * gv[j] + bv[j];
            if (dstf) *((f32x4*)(dstf + (size_t)m * 1024) + lane + 64 * j) = y;
            if (dstb) { u32x2 w; w.x = cvtpk(y.x, y.y); w.y = cvtpk(y.z, y.w); *((u32x2*)(dstb + (size_t)m * 1024) + lane + 64 * j) = w; } }
    }
}
struct ConvW { f32x4 w[4][2]; f32x4 b[2]; };
__device__ __forceinline__ void conv_load_w(ConvW& cw, const float* conv_w, const float* conv_b, int xch) {
#pragma unroll
    for (int j = 0; j < 4; ++j) { cw.w[j][0] = *(const f32x4*)(conv_w + j * 3072 + xch); cw.w[j][1] = *(const f32x4*)(conv_w + j * 3072 + xch + 4); }
    cw.b[0] = *(const f32x4*)(conv_b + xch); cw.b[1] = *(const f32x4*)(conv_b + xch + 4);
}
__device__ __forceinline__ void conv8(const bf16* P, int row, int xch, const ConvW& cw, float (&o)[8]) {
    f32x4 a0 = cw.b[0], a1 = cw.b[1];
#pragma unroll
    for (int j = 0; j < 4; ++j) { const int r = row - 3 + j;
        if (r >= 0) { const u32x4 v = *(const u32x4*)(P + (size_t)r * LDP + PC_XBC + xch);
            a0[0] += cw.w[j][0][0] * bflo(v.x); a0[1] += cw.w[j][0][1] * bfhi(v.x); a0[2] += cw.w[j][0][2] * bflo(v.y); a0[3] += cw.w[j][0][3] * bfhi(v.y);
            a1[0] += cw.w[j][1][0] * bflo(v.z); a1[1] += cw.w[j][1][1] * bfhi(v.z); a1[2] += cw.w[j][1][2] * bflo(v.w); a1[3] += cw.w[j][1][3] * bfhi(v.w); } }
#pragma unroll
    for (int i = 0; i < 4; ++i) { o[i] = siluf_(a0[i]); o[4 + i] = siluf_(a1[i]); }
}
template <bool TR> __device__ __forceinline__ void conv_tile8(LAS unsigned char* dst, const bf16* P, int row0, int xch, int cgl, int lr,
                                                           const float* conv_w, const float* conv_b, const LAS float* sw) {
    ConvW cw; conv_load_w(cw, conv_w, conv_b, xch);
    u32x4 raw[11];
#pragma unroll
    for (int k = 0; k < 11; ++k) { const int r = row0 + lr * 8 - 3 + k; raw[k] = (r >= 0) ? *(const u32x4*)(P + (size_t)r * LDP + PC_XBC + xch) : (u32x4){0u, 0u, 0u, 0u}; }
    unsigned pk[8][2];
#pragma unroll
    for (int lp = 0; lp < 4; ++lp) { float o[2][8];
#pragma unroll
        for (int q = 0; q < 2; ++q) { f32x4 a0 = cw.b[0], a1 = cw.b[1];
#pragma unroll
            for (int j = 0; j < 4; ++j) { const u32x4 v = raw[2 * lp + q + j];
                a0[0] += cw.w[j][0][0] * bflo(v.x); a0[1] += cw.w[j][0][1] * bfhi(v.x); a0[2] += cw.w[j][0][2] * bflo(v.y); a0[3] += cw.w[j][0][3] * bfhi(v.y);
                a1[0] += cw.w[j][1][0] * bflo(v.z); a1[1] += cw.w[j][1][1] * bfhi(v.z); a1[2] += cw.w[j][1][2] * bflo(v.w); a1[3] += cw.w[j][1][3] * bfhi(v.w); }
            const float sc = sw ? sw[lr * 8 + 2 * lp + q] : 1.0f;
#pragma unroll
            for (int i = 0; i < 4; ++i) { o[q][i] = siluf_(a0[i]) * sc; o[q][4 + i] = siluf_(a1[i]) * sc; } }
        if (TR) {
#pragma unroll
            for (int e = 0; e < 8; ++e) pk[e][lp & 1] = cvtpk(o[0][e], o[1][e]);
            if (lp & 1) {
#pragma unroll
                for (int e = 0; e < 8; ++e) *(LAS u32x2*)(dst + (cgl * 8 + e) * 272 + lr * 16 + (lp >> 1) * 8) = (u32x2){pk[e][0], pk[e][1]}; }
        } else {
#pragma unroll
            for (int q = 0; q < 2; ++q) { u32x4 pw; pw.x = cvtpk(o[q][0], o[q][1]); pw.y = cvtpk(o[q][2], o[q][3]); pw.z = cvtpk(o[q][4], o[q][5]); pw.w = cvtpk(o[q][6], o[q][7]);
                *(LAS u32x4*)(dst + (lr * 8 + 2 * lp + q) * 272 + cgl * 16) = pw; } } }
}
__device__ __forceinline__ void chunk_decay(const float* dtbuf, int row0, int head, float bias, float Aneg, int lane, float& dt0, float& dt1, float& ac0, float& ac1) {
    float r0 = dtbuf[(size_t)(row0 + 2 * lane) * 32 + head] + bias, r1 = dtbuf[(size_t)(row0 + 2 * lane + 1) * 32 + head] + bias;
    dt0 = fmaxf(r0, 0.f) + log1pf(__expf(-fabsf(r0))); dt1 = fmaxf(r1, 0.f) + log1pf(__expf(-fabsf(r1)));
    const float a0 = dt0 * Aneg, a1 = dt1 * Aneg;
    float s = a0 + a1;
#pragma unroll
    for (int o = 1; o < 64; o <<= 1) { const float t = __shfl_up(s, o); if (lane >= o) s += t; }
    ac1 = s; ac0 = s - a1;
}

#define XB_TMO      128
#define XB_XCNT(j)  (256  + 64 * (j))
#define XB_XSUB(j)  (1280 + 64 * (j))
#define XB_XGEN(j)  (2304 + 64 * (j))
#define XB_TOP      3328
#define XB_TOPGEN   3392
#define XCD_BAR_WORDS 3456
#define XB_SPIN_CAP (1u << 18)

__device__ __forceinline__ unsigned xb_ld(unsigned* p)              { return __hip_atomic_load(p, __ATOMIC_RELAXED, __HIP_MEMORY_SCOPE_AGENT); }
__device__ __forceinline__ unsigned xb_add(unsigned* p, unsigned v) { return __hip_atomic_fetch_add(p, v, __ATOMIC_RELAXED, __HIP_MEMORY_SCOPE_AGENT); }
__device__ __forceinline__ unsigned xb_xcc_id() { return (unsigned)__builtin_amdgcn_s_getreg((3 << 11) | 20) & 0xFu; }
#define XB_SPIN(cond, bar) do { unsigned _sp = 0; while (cond) { __builtin_amdgcn_s_sleep(1); \
    if ((++_sp & 255u) == 0u) { if (xb_ld(&(bar)[XB_TMO])) break; if (_sp > XB_SPIN_CAP) { atomicAdd(&(bar)[XB_TMO], 1u); break; } } } } while (0)

struct XcdBarrier {
    unsigned* bar; unsigned x;
    volatile LAS unsigned* st;
};

__device__ __forceinline__ XcdBarrier xcd_barrier_post(unsigned* bar, volatile LAS unsigned* st) {
    XcdBarrier b; b.bar = bar; b.x = xb_xcc_id(); b.st = st;
    if (threadIdx.x == 0) (void)xb_add(&bar[XB_XCNT(b.x)], 1u);
    return b;
}
__device__ __forceinline__ void xcd_barrier_complete(unsigned* bar, unsigned x, unsigned& nloc, unsigned& nx) {
    const unsigned G = gridDim.x * gridDim.y * gridDim.z;
    unsigned sum, cnt, mine, sp = 0u;
    for (;;) {
        sum = 0u; cnt = 0u; mine = 0u;
#pragma unroll
        for (unsigned j = 0; j < 16; ++j) { const unsigned c = xb_ld(&bar[XB_XCNT(j)]); sum += c; cnt += (c > 0u) ? 1u : 0u; mine = (j == x) ? c : mine; }
        if (sum == G) break;
        __builtin_amdgcn_s_sleep(1);
        if ((++sp & 255u) == 0u) { if (xb_ld(&bar[XB_TMO])) break; if (sp > XB_SPIN_CAP) { atomicAdd(&bar[XB_TMO], 1u); break; } }
    }
    nloc = mine > 0u ? mine : 1u; nx = cnt > 0u ? cnt : 1u;
}

__device__ __forceinline__ void xcd_barrier(const XcdBarrier& b) {
    asm volatile("s_waitcnt vmcnt(0)" ::: "memory");
    __syncthreads();
    if (threadIdx.x == 0) {
        unsigned* bar = b.bar;
        __builtin_amdgcn_s_waitcnt(0);
        unsigned nloc = b.st[0], nx = b.st[1];
        if (nloc == 0u) { xcd_barrier_complete(bar, b.x, nloc, nx); b.st[0] = nloc; b.st[1] = nx; }
        const unsigned old = xb_add(&bar[XB_XSUB(b.x)], 1u);
        const unsigned gen = old / nloc;
        if (old + 1u == (gen + 1u) * nloc) {
            __builtin_amdgcn_fence(__ATOMIC_RELEASE, "agent");
            asm volatile("s_waitcnt vmcnt(0)" ::: "memory");
            const unsigned og = xb_add(&bar[XB_TOP], 1u);
            const unsigned tg = og / nx;
            if (og + 1u == (tg + 1u) * nx) xb_add(&bar[XB_TOPGEN], 1u);
            else XB_SPIN(xb_ld(&bar[XB_TOPGEN]) == tg, bar);
            __builtin_amdgcn_fence(__ATOMIC_ACQUIRE, "agent");
            xb_add(&bar[XB_XGEN(b.x)], 1u);
            asm volatile("s_waitcnt vmcnt(0)" ::: "memory");
        } else {
            XB_SPIN(xb_ld(&bar[XB_XGEN(b.x)]) == gen, bar);
            __builtin_amdgcn_fence(__ATOMIC_ACQUIRE, "agent");
            asm volatile("s_waitcnt vmcnt(0)" ::: "memory");
        }
    }
    __syncthreads();
}

constexpr int AT_QS = 0, AT_KS = 18432, AT_VT = 55296, AT_PS = 91136, AT_END = AT_PS + 8 * 16 * 336;
static_assert(AT_END <= 147456, "attention LDS");
__device__ __forceinline__ void attn_unit(LAS unsigned char* lds, bf16* P, int blk, int h, float sink, int tid_in) {
    int tid = tid_in; asm volatile("" : "+v"(tid));
    const int lane = tid & 63, w = __builtin_amdgcn_readfirstlane(tid >> 6), fr = lane & 15, kg = lane >> 4;
    const int row0 = blk * 128, g = h >> 2;
#pragma unroll
    for (int i = 0; i < 2; ++i) { const int idx = tid + 512 * i, r = idx >> 3, ch = idx & 7;
        const u32x4 v = *(const u32x4*)(P + (size_t)(row0 + r) * LDP + PC_Q + h * 64 + ch * 8); *(LAS u32x4*)(lds + AT_QS + r * 144 + ch * 16) = v; }
#pragma unroll
    for (int i = 0; i < 4; ++i) { const int idx = tid + 512 * i, kj = idx >> 3, ch = idx & 7; const int srow = (blk > 0) ? row0 - 128 + kj : row0 + (kj & 127);
        const u32x4 v = *(const u32x4*)(P + (size_t)srow * LDP + PC_K + g * 64 + ch * 8); *(LAS u32x4*)(lds + AT_KS + kj * 144 + ch * 16) = v; }
#pragma unroll
    for (int i = 0; i < 4; ++i) { const int idx = tid + 512 * i, kj = idx & 255, ch = idx >> 8; const int srow = (blk > 0) ? row0 - 128 + kj : row0 + (kj & 127);
        const u32x4 v = *(const u32x4*)(P + (size_t)srow * LDP + PC_V + g * 64 + ch * 8);
        LAS unsigned short* d = (LAS unsigned short*)(lds + AT_VT + (ch * 8) * 560 + kj * 2);
        d[0 * 280] = (unsigned short)(v.x & 0xffffu); d[1 * 280] = (unsigned short)(v.x >> 16); d[2 * 280] = (unsigned short)(v.y & 0xffffu); d[3 * 280] = (unsigned short)(v.y >> 16);
        d[4 * 280] = (unsigned short)(v.z & 0xffffu); d[5 * 280] = (unsigned short)(v.z >> 16); d[6 * 280] = (unsigned short)(v.w & 0xffffu); d[7 * 280] = (unsigned short)(v.w >> 16); }
    for (int idx = tid; idx < 64 * 12; idx += 512) { const int d = idx / 12, wv = idx % 12; *(LAS unsigned*)(lds + AT_VT + d * 560 + 512 + wv * 4) = 0u; }
    { const int row = lane >> 2, part = lane & 3; *(LAS u32x2*)(lds + AT_PS + w * 5376 + row * 336 + 288 + part * 8) = (u32x2){0u, 0u}; }
    __syncthreads();
    bf16x8 qf[2];
#pragma unroll
    for (int ks = 0; ks < 2; ++ks) qf[ks] = *(const LAS bf16x8*)(lds + AT_QS + (16 * w + fr) * 144 + (32 * ks + 8 * kg) * 2);
    f32x4 s[9];
#pragma unroll
    for (int ti = 0; ti < 9; ++ti) { const int t = w + ti; f32x4 acc = {0.f, 0.f, 0.f, 0.f};
#pragma unroll
        for (int ks = 0; ks < 2; ++ks) { const bf16x8 kf = *(const LAS bf16x8*)(lds + AT_KS + (16 * t + fr) * 144 + (32 * ks + 8 * kg) * 2); acc = MFMA16(kf, qf[ks], acc); }
        s[ti] = acc; }
    const int qi = 128 + 16 * w + fr; float mx = sink;
#pragma unroll
    for (int ti = 0; ti < 9; ++ti)
#pragma unroll
        for (int j = 0; j < 4; ++j) { const int kj = 16 * (w + ti) + 4 * kg + j, d = qi - kj; const bool valid = (d >= 0) && (d < 128) && (blk > 0 || kj >= 128);
            const float v = valid ? s[ti][j] * 0.125f : -INFINITY; s[ti][j] = v; mx = fmaxf(mx, v); }
    mx = fmaxf(mx, __shfl_xor(mx, 16)); mx = fmaxf(mx, __shfl_xor(mx, 32));
    float sum = 0.f;
#pragma unroll
    for (int ti = 0; ti < 9; ++ti) {
#pragma unroll
        for (int j = 0; j < 4; ++j) { const float p = __expf(s[ti][j] - mx); s[ti][j] = p; sum += p; }
        u32x2 pw; pw.x = cvtpk(s[ti][0], s[ti][1]); pw.y = cvtpk(s[ti][2], s[ti][3]);
        *(LAS u32x2*)(lds + AT_PS + w * 5376 + fr * 336 + (16 * ti + 4 * kg) * 2) = pw; }
    sum += __shfl_xor(sum, 16); sum += __shfl_xor(sum, 32);
    const float inv = 1.0f / (sum + __expf(sink - mx));
    LDS_WAIT(); asm volatile("" ::: "memory");
    f32x4 o[4];
#pragma unroll
    for (int dt = 0; dt < 4; ++dt) o[dt] = (f32x4){0.f, 0.f, 0.f, 0.f};
#pragma unroll
    for (int ks = 0; ks < 5; ++ks) { const bf16x8 pf = *(const LAS bf16x8*)(lds + AT_PS + w * 5376 + fr * 336 + (32 * ks + 8 * kg) * 2);
#pragma unroll
        for (int dt = 0; dt < 4; ++dt) { const bf16x8 vf = *(const LAS bf16x8*)(lds + AT_VT + (16 * dt + fr) * 560 + (16 * w + 32 * ks + 8 * kg) * 2); o[dt] = MFMA16(vf, pf, o[dt]); } }
    bf16* orow = P + (size_t)(row0 + 16 * w + fr) * LDP + PC_Q + h * 64 + 4 * kg;
#pragma unroll
    for (int dt = 0; dt < 4; ++dt) { u32x2 ow; ow.x = cvtpk(o[dt][0] * inv, o[dt][1] * inv); ow.y = cvtpk(o[dt][2] * inv, o[dt][3] * inv); *(u32x2*)(orow + 16 * dt) = ow; }
    __syncthreads();
}

constexpr int S1_BT = 0, S1_XW = 34816, S1_SW = 104448;
__device__ __forceinline__ void s1_unit(LAS unsigned char* lds, const bf16* P, const float* dtbuf, float* dec, bf16* states, int c, int g,
                                        const float* conv_w, const float* conv_b, const float* dt_bias, const float* a_log, int tid_in) {
    int tid = tid_in; asm volatile("" : "+v"(tid));
    const int lane = tid & 63, w = __builtin_amdgcn_readfirstlane(tid >> 6), fr = lane & 15, kg = lane >> 4;
    const int row0 = c * 128;
    { const int hh = 8 * g + w; const float Aneg = -__expf(a_log[hh]); float dt0, dt1, ac0, ac1;
      chunk_decay(dtbuf, row0, hh, dt_bias[hh], Aneg, lane, dt0, dt1, ac0, ac1);
      const float tot = __shfl(ac1, 63);
      LAS float* sw = (LAS float*)(lds + S1_SW) + w * 128;
      sw[2 * lane] = __expf(tot - ac0) * dt0; sw[2 * lane + 1] = __expf(tot - ac1) * dt1;
      if (lane == 63) dec[c * 32 + hh] = __expf(tot); }
    __syncthreads();
    if (tid < 256) { const int lr = tid & 15, cg = tid >> 4; conv_tile8<true>(lds + S1_BT, P, row0, 2048 + g * 128 + cg * 8, cg, lr, conv_w, conv_b, nullptr); }
#pragma unroll 1
    for (int half = 0; half < 2; ++half) {
        if (half) __syncthreads();
        { const int lr = tid & 15, cg = tid >> 4; conv_tile8<true>(lds + S1_XW, P, row0, g * 512 + half * 256 + cg * 8, cg, lr, conv_w, conv_b, (const LAS float*)(lds + S1_SW) + (half * 4 + (cg >> 3)) * 128); }
        __syncthreads();
        const int hl = w >> 1, ph = w & 1;
        f32x4 acc[2][8];
#pragma unroll
        for (int pt = 0; pt < 2; ++pt)
#pragma unroll
            for (int nt = 0; nt < 8; ++nt) acc[pt][nt] = (f32x4){0.f, 0.f, 0.f, 0.f};
#pragma unroll
        for (int ks = 0; ks < 4; ++ks) { bf16x8 xf[2];
#pragma unroll
            for (int pt = 0; pt < 2; ++pt) xf[pt] = *(const LAS bf16x8*)(lds + S1_XW + (hl * 64 + ph * 32 + 16 * pt + fr) * 272 + (32 * ks + 8 * kg) * 2);
#pragma unroll
            for (int nt = 0; nt < 8; ++nt) { const bf16x8 bfr = *(const LAS bf16x8*)(lds + S1_BT + (16 * nt + fr) * 272 + (32 * ks + 8 * kg) * 2);
#pragma unroll
                for (int pt = 0; pt < 2; ++pt) acc[pt][nt] = MFMA16(bfr, xf[pt], acc[pt][nt]); } }
        const int hh = 8 * g + half * 4 + hl;
#pragma unroll
        for (int pt = 0; pt < 2; ++pt) { bf16* sp = states + ((size_t)(c * 32 + hh) * 64 + ph * 32 + 16 * pt + fr) * 128 + 4 * kg;
#pragma unroll
            for (int nt = 0; nt < 8; ++nt) { u32x2 ow; ow.x = cvtpk(acc[pt][nt][0], acc[pt][nt][1]); ow.y = cvtpk(acc[pt][nt][2], acc[pt][nt][3]); *(u32x2*)(sp + 16 * nt) = ow; } }
    }
    __syncthreads();
}
__device__ __forceinline__ void scan_phase(bf16* states, const float* dec, int gtid, int nthr) {
    for (int e = gtid; e < 131072; e += nthr) { const int head = e >> 12; unsigned* p = (unsigned*)states + (size_t)head * 4096 + (e & 4095);
        float h0 = 0.f, h1 = 0.f;
#pragma unroll 8
        for (int c = 0; c < 64; ++c) { const float d = dec[c * 32 + head]; const unsigned v = p[(size_t)c * 131072]; p[(size_t)c * 131072] = cvtpk(h0, h1); h0 = d * h0 + bflo(v); h1 = d * h1 + bfhi(v); } }
}
constexpr int S3_CS = 0, S3_R = 34816, S3_AC = 104448, S3_DT = 108544;
__device__ __forceinline__ void s3_unit(LAS unsigned char* lds, bf16* P, const float* dtbuf, const bf16* states, int c, int g,
                                        const float* conv_w, const float* conv_b, const float* dt_bias, const float* a_log, const float* d_skip, const float* norm_w, int tid_in) {
    int tid = tid_in; asm volatile("" : "+v"(tid));
    const int lane = tid & 63, w = __builtin_amdgcn_readfirstlane(tid >> 6), fr = lane & 15, kg = lane >> 4;
    const int row0 = c * 128;
    { const int hh = 8 * g + w; const float Aneg = -__expf(a_log[hh]); float dt0, dt1, ac0, ac1;
      chunk_decay(dtbuf, row0, hh, dt_bias[hh], Aneg, lane, dt0, dt1, ac0, ac1);
      LAS float* ac = (LAS float*)(lds + S3_AC) + w * 128; LAS float* dv = (LAS float*)(lds + S3_DT) + w * 128;
      ac[2 * lane] = ac0; ac[2 * lane + 1] = ac1; dv[2 * lane] = dt0; dv[2 * lane + 1] = dt1; }
    { const int which = tid >> 8, t2 = tid & 255, cg = t2 & 15, lr = t2 >> 4;
      conv_tile8<false>(lds + (which ? S3_R : S3_CS), P, row0, (which ? 2048 : 2560) + g * 128 + cg * 8, cg, lr, conv_w, conv_b, nullptr); }
    __syncthreads();
    f32x4 cb[8];
    { bf16x8 cf[4];
#pragma unroll
    for (int ks = 0; ks < 4; ++ks) cf[ks] = *(const LAS bf16x8*)(lds + S3_CS + (16 * w + fr) * 272 + (32 * ks + 8 * kg) * 2);
#pragma unroll
    for (int ts = 0; ts < 8; ++ts) { f32x4 acc = {0.f, 0.f, 0.f, 0.f};
        if (ts <= w) {
#pragma unroll
            for (int ks = 0; ks < 4; ++ks) { const bf16x8 bfr = *(const LAS bf16x8*)(lds + S3_R + (16 * ts + fr) * 272 + (32 * ks + 8 * kg) * 2); acc = MFMA16(bfr, cf[ks], acc); } }
        cb[ts] = acc; } }
    asm volatile("" ::: "memory");
    float ssq[4] = {0.f, 0.f, 0.f, 0.f};
    const int lme = 16 * w + fr;
#pragma unroll 1
    for (int hidx = 0; hidx < 8; ++hidx) {
        if ((hidx & 3) == 0) {
            __syncthreads();
            { const int half = hidx >> 2, lr = tid & 15, cg = tid >> 4; conv_tile8<true>(lds + S3_R, P, row0, g * 512 + half * 256 + cg * 8, cg, lr, conv_w, conv_b, nullptr); }
            __syncthreads();
        }
        const int hl = hidx & 3, hh = 8 * g + hidx;
        const LAS float* ac = (const LAS float*)(lds + S3_AC) + hidx * 128; const LAS float* dv = (const LAS float*)(lds + S3_DT) + hidx * 128;
        const float acl = ac[lme];
        f32x4 accD[4], accO[4];
#pragma unroll
        for (int pt = 0; pt < 4; ++pt) { accD[pt] = (f32x4){0.f, 0.f, 0.f, 0.f}; accO[pt] = (f32x4){0.f, 0.f, 0.f, 0.f}; }
#pragma unroll
        for (int ks = 0; ks < 4; ++ks) {
            if (2 * ks <= w) { float mv[8];
#pragma unroll
                for (int tsub = 0; tsub < 2; ++tsub) { const int ts = 2 * ks + tsub; const f32x4 as = *(const LAS f32x4*)(ac + 16 * ts + 4 * kg), ds = *(const LAS f32x4*)(dv + 16 * ts + 4 * kg);
#pragma unroll
                    for (int j = 0; j < 4; ++j) { const int sidx = 16 * ts + 4 * kg + j; mv[4 * tsub + j] = (sidx <= lme) ? cb[ts][j] * __expf(acl - as[j]) * ds[j] : 0.f; } }
                u32x4 mw; mw.x = cvtpk(mv[0], mv[1]); mw.y = cvtpk(mv[2], mv[3]); mw.z = cvtpk(mv[4], mv[5]); mw.w = cvtpk(mv[6], mv[7]);
                const bf16x8 mf = __builtin_bit_cast(bf16x8, mw);
#pragma unroll
                for (int pt = 0; pt < 4; ++pt) { const int chan = hl * 64 + 16 * pt + fr;
                    const u32x2 lo = *(const LAS u32x2*)(lds + S3_R + chan * 272 + (32 * ks + 4 * kg) * 2), hi = *(const LAS u32x2*)(lds + S3_R + chan * 272 + (32 * ks + 16 + 4 * kg) * 2);
                    const u32x4 xw = {lo.x, lo.y, hi.x, hi.y}; accD[pt] = MFMA16(mf, __builtin_bit_cast(bf16x8, xw), accD[pt]); } } }
        { bf16x8 cf2[4];
#pragma unroll
          for (int ks = 0; ks < 4; ++ks) cf2[ks] = *(const LAS bf16x8*)(lds + S3_CS + (16 * w + fr) * 272 + (32 * ks + 8 * kg) * 2);
#pragma unroll
        for (int pt = 0; pt < 4; ++pt) { const bf16* pp = states + ((size_t)(c * 32 + hh) * 64 + 16 * pt + fr) * 128 + 8 * kg;
#pragma unroll
            for (int ks = 0; ks < 4; ++ks) { const bf16x8 pf = *(const bf16x8*)(pp + 32 * ks); accO[pt] = MFMA16(cf2[ks], pf, accO[pt]); }
            asm volatile("" ::: "memory"); } }
        const f32x4 al = *(const LAS f32x4*)(ac + 16 * w + 4 * kg); f32x4 ea;
#pragma unroll
        for (int j = 0; j < 4; ++j) ea[j] = __expf(al[j]);
        const float Dh = d_skip[hh];
#pragma unroll
        for (int pt = 0; pt < 4; ++pt) { const u32x2 xv = *(const LAS u32x2*)(lds + S3_R + (hl * 64 + 16 * pt + fr) * 272 + (16 * w + 4 * kg) * 2);
            const float xs[4] = {bflo(xv.x), bfhi(xv.x), bflo(xv.y), bfhi(xv.y)};
            bf16* zp = P + (size_t)(row0 + 16 * w + 4 * kg) * LDP + PC_Z + hh * 64 + 16 * pt + fr;
#pragma unroll
            for (int j = 0; j < 4; ++j) { const float y = accD[pt][j] + ea[j] * accO[pt][j] + Dh * xs[j]; const float z = __uint_as_float((unsigned)zp[(size_t)j * LDP] << 16);
                const unsigned ub = cvtpk(y * siluf_(z), 0.f) & 0xffffu; const float ur = __uint_as_float(ub << 16); ssq[j] += ur * ur; zp[(size_t)j * LDP] = (bf16)ub; } }
    }
    float rs[4];
#pragma unroll
    for (int j = 0; j < 4; ++j) { float v = ssq[j]; v += __shfl_xor(v, 1); v += __shfl_xor(v, 2); v += __shfl_xor(v, 4); v += __shfl_xor(v, 8); rs[j] = 1.0f / sqrtf(v * (1.0f / 512.0f) + RMS_EPS); }
#pragma unroll 1
    for (int hidx = 0; hidx < 8; ++hidx)
#pragma unroll
        for (int pt = 0; pt < 4; ++pt) { const int col = (8 * g + hidx) * 64 + 16 * pt + fr; const float nw = norm_w[col];
            bf16* up = P + (size_t)(row0 + 16 * w + 4 * kg) * LDP + PC_Z + col;
#pragma unroll
            for (int j = 0; j < 4; ++j) { const float u = __uint_as_float((unsigned)up[(size_t)j * LDP] << 16); up[(size_t)j * LDP] = (bf16)(cvtpk(u * rs[j] * nw, 0.f) & 0xffffu); } }
    __syncthreads();
}
typedef __attribute__((address_space(4))) const char* kptr_t;
typedef void* vp_t; typedef __attribute__((address_space(4))) const vp_t* kpp_t;
#define KARG_PTR(off) ({ kptr_t kp_ = (kptr_t)__builtin_amdgcn_kernarg_segment_ptr(); asm volatile("" : "+s"(kp_)); *(kpp_t)(kp_ + (off)); })
#define IN(i) ((const float*)KARG_PTR(8 * (i)))
#define OUTP ((float*)KARG_PTR(192))
#define WSP ((unsigned char*)KARG_PTR(200))
#define Wgu ((bf16*)(WSP + WS_WGU))
#define Wd ((bf16*)(WSP + WS_WD))
#define Win ((bf16*)(WSP + WS_WIN))
#define Wcat ((bf16*)(WSP + WS_WCAT))
#define Wout ((bf16*)(WSP + WS_WOUT))
#define x1f ((float*)(WSP + WS_X1F))
#define big ((bf16*)(WSP + WS_BIG))
#define dtbuf ((float*)(WSP + WS_DT))
#define dec ((float*)(WSP + WS_DEC))
#define xb ((bf16*)((unsigned char*)OUTP + DO_XB))
#define states ((bf16*)((unsigned char*)OUTP + DO_ST))
struct Args { const float* in[24]; float* out; unsigned char* ws; };
__global__ void __launch_bounds__(NTHR, 2) mega_fwd(Args a) {
    extern __shared__ __attribute__((aligned(16))) unsigned char lds_raw[];
    LAS unsigned char* lds = (LAS unsigned char*)lds_raw;
    cg::grid_group grid = cg::this_grid();
    const int G = gridDim.x, bid = blockIdx.x, NGW = G * NWAVES, nthr = G * NTHR;
#define TID_FRESH() ({ int t_ = threadIdx.x; asm volatile("" : "+v"(t_)); t_; })
#define PHASE_IDS const int tid = TID_FRESH(); const int lane = tid & 63, wave = __builtin_amdgcn_readfirstlane(tid >> 6), gw = bid * NWAVES + wave, gtid = bid * NTHR + tid; (void)lane; (void)gw; (void)gtid; LAS float* scr = (LAS float*)(lds + wave * 16384); (void)scr;
    volatile LAS unsigned* MISC = (volatile LAS unsigned*)(lds + LDS_BYTES - 64);
    if (threadIdx.x < 16) MISC[threadIdx.x] = 0u;
    __syncthreads();
    (void)xcd_barrier_post((unsigned*)(WSP + WS_CTL), MISC + 8);
#define GRID_BAR() do { XcdBarrier b_; b_.bar = (unsigned*)(WSP + WS_CTL); b_.x = xb_xcc_id(); b_.st = (volatile LAS unsigned*)(lds + LDS_BYTES - 64) + 8; xcd_barrier(b_); } while (0)

    { PHASE_IDS
    ffn_weight_items(IN(1), IN(2), IN(3), Wgu, Wd, scr, gw, NGW, lane);
    for (int it = gw; it < 16 * 273; it += NGW) { const int kb = it / 273, nb = it % 273, n0 = nb * 32; tr_item(IN(6), 8736, kb * 64, n0, Win, 1024, map_in(n0), kb * 64, scr, lane); }
    for (int it = gw; it < 512 + 1024 + 512; it += NGW) { int r = it;
        if (r < 512) { tr_item(IN(14), 1024, (r >> 5) * 64, (r & 31) * 32, Wcat, 1024, (r & 31) * 32, (r >> 5) * 64, scr, lane); continue; } r -= 512;
        if (r < 1024) { tr_item(IN(15), 1024, (r >> 5) * 64, (r & 31) * 32, Wcat + (size_t)1024 * 1024, 2048, (r & 31) * 32, (r >> 5) * 64, scr, lane); continue; } r -= 1024;
        tr_item(IN(16), 1024, (r >> 5) * 64, (r & 31) * 32, Wout, 1024, (r & 31) * 32, (r >> 5) * 64, scr, lane); }
    for (int i = gtid; i < 224 * 1024 / 8; i += nthr) *((u32x4*)(Win + (size_t)8736 * 1024) + i) = (u32x4){0u, 0u, 0u, 0u};
    { const float* xin = IN(0); bf16* xbo = xb;
    for (int i = gtid; i < M * 1024 / 8; i += nthr) { const f32x4 v0 = *((const f32x4*)xin + 2 * (size_t)i), v1 = *((const f32x4*)xin + 2 * (size_t)i + 1);
        u32x4 o; o.x = cvtpk(v0.x, v0.y); o.y = cvtpk(v0.z, v0.w); o.z = cvtpk(v1.x, v1.y); o.w = cvtpk(v1.z, v1.w); *((u32x4*)xbo + i) = o; } } }
    grid.sync();
#ifndef SKIP_GEMM1
    { pg8::Gemm g{xb, Wgu, M, 2 * DFF, 1024, 1024}; pg8::StaticOrder S; S.init(M, 2 * DFF, G, bid); pg8::EpiSwiGLU E{0, big, DFF};
      pg8::gemm_phase<pg8::EpiSwiGLU, pg8::StaticOrder, true, true>(lds, g, S, E); }
#endif
    GRID_BAR();
#ifndef SKIP_GEMM2
    { pg8::Gemm g{big, Wd, M, 1024, DFF, DFF}; pg8::StaticOrder S; S.init(M, 1024, G, bid); pg8::EpiResid E{0, IN(0), x1f, 1024, ALPHA, 0.5f};
      pg8::gemm_phase<pg8::EpiResid, pg8::StaticOrder, true, true>(lds, g, S, E); }
#endif
    GRID_BAR();
    { PHASE_IDS ln_rows(x1f, x1f, xb, IN(4), IN(5), M, gw, NGW, lane); }
    GRID_BAR();
#pragma unroll 1
    for (int b = 0; b < 2; ++b) {
#ifndef SKIP_GEMM3
        { pg8::Gemm g{xb + (size_t)b * MB * 1024, Win, MB, NPROJ, 1024, 1024}; pg8::StaticOrder S; S.init(MB, NPROJ, G, bid); pg8::EpiInProj E{0, big, LDP, dtbuf};
          pg8::gemm_phase<pg8::EpiInProj, pg8::StaticOrder, true, true>(lds, g, S, E); }
#endif
        GRID_BAR();
#ifndef SKIP_S1
        for (int u = bid; u < 256; u += G) s1_unit(lds, big, dtbuf, dec, states, u >> 2, u & 3, IN(7), IN(8), IN(9), IN(10), threadIdx.x);
#endif
#ifndef SKIP_ATTN
        for (int u = bid; u < 1024; u += G) attn_unit(lds, big, u >> 4, u & 15, IN(13)[u & 15], threadIdx.x);
#endif
        GRID_BAR();
        { PHASE_IDS scan_phase(states, dec, gtid, nthr); }
        GRID_BAR();
#ifndef SKIP_S3
        for (int u = bid; u < 256; u += G) s3_unit(lds, big, dtbuf, states, u >> 2, u & 3, IN(7), IN(8), IN(9), IN(10), IN(11), IN(12), threadIdx.x);
#endif
        GRID_BAR();
#ifndef SKIP_G4
        { pg8::Gemm g{big + PC_Q, Wcat, MB, 1024, 1024, LDP}; pg8::StaticOrder S; S.init(MB, 1024, G, bid); pg8::EpiGate<0> E{0, big + PC_GA, LDP, PC_GS - PC_GA, nullptr, 0};
          pg8::gemm_phase<pg8::EpiGate<0>, pg8::StaticOrder, true, true>(lds, g, S, E); }
        { pg8::Gemm g{big + PC_Z, Wcat + (size_t)1024 * 1024, MB, 1024, 2048, LDP}; pg8::StaticOrder S; S.init(MB, 1024, G, bid); pg8::EpiGate<1> E{0, big + PC_GA, LDP, PC_GS - PC_GA, xb + (size_t)b * MB * 1024, 1024};
          pg8::gemm_phase<pg8::EpiGate<1>, pg8::StaticOrder, true, true>(lds, g, S, E); }
#endif
        GRID_BAR();
    }
    { pg8::Gemm g{xb, Wout, M, 1024, 1024, 1024}; pg8::StaticOrder S; S.init(M, 1024, G, bid); pg8::EpiResid E{0, x1f, x1f, 1024, ALPHA, 1.0f};
      pg8::gemm_phase<pg8::EpiResid, pg8::StaticOrder, true, true>(lds, g, S, E); }
    GRID_BAR();
    { PHASE_IDS ffn_weight_items(IN(19), IN(20), IN(21), Wgu, Wd, scr, gw, NGW, lane);
      ln_rows(x1f, x1f, xb, IN(17), IN(18), M, gw, NGW, lane); }
    GRID_BAR();
#ifndef SKIP_GEMM5
    { pg8::Gemm g{xb, Wgu, M, 2 * DFF, 1024, 1024}; pg8::StaticOrder S; S.init(M, 2 * DFF, G, bid); pg8::EpiSwiGLU E{0, big, DFF};
      pg8::gemm_phase<pg8::EpiSwiGLU, pg8::StaticOrder, true, true>(lds, g, S, E); }
#endif
    GRID_BAR();
#ifndef SKIP_GEMM6
    { pg8::Gemm g{big, Wd, M, 1024, DFF, DFF}; pg8::StaticOrder S; S.init(M, 1024, G, bid); pg8::EpiResid E{0, x1f, OUTP, 1024, ALPHA, 0.5f};
      pg8::gemm_phase<pg8::EpiResid, pg8::StaticOrder, true, true>(lds, g, S, E); }
#endif
    GRID_BAR();
    { PHASE_IDS ln_rows(OUTP, OUTP, nullptr, IN(22), IN(23), M, gw, NGW, lane); }
}

#undef Wgu
#undef Wd
#undef Win
#undef Wcat
#undef Wout
#undef x1f
#undef big
#undef dtbuf
#undef dec
#undef xb
#undef states
extern "C" void kernel_launch(void* const* d_in, const int* in_sizes, int n_in, void* d_out, int out_size, void* d_ws, size_t ws_size, hipStream_t stream) {
    static int grid = 0;
    if (grid == 0) {
        if (n_in != 24 || out_size != M * 1024 || ws_size < WS_END) { fprintf(stderr, "kernel_launch: unexpected shapes (n_in %d out %d ws %zu)\n", n_in, out_size, ws_size); grid = -1; return; }
        int dev = 0, cus = 0, per_cu = 0;
        (void)hipGetDevice(&dev); (void)hipDeviceGetAttribute(&cus, hipDeviceAttributeMultiprocessorCount, dev);
        (void)hipFuncSetAttribute((const void*)mega_fwd, hipFuncAttributeMaxDynamicSharedMemorySize, LDS_BYTES);
        (void)hipOccupancyMaxActiveBlocksPerMultiprocessor(&per_cu, (const void*)mega_fwd, NTHR, LDS_BYTES);
        if (per_cu < 1) per_cu = 1;
        grid = cus * per_cu; if (grid > 256) grid = 256;
        (void)hipGetLastError();
    }
    if (grid < 0) return;
    if (hipMemsetAsync((char*)d_ws + WS_CTL, 0, 65536, stream) != hipSuccess) { fprintf(stderr, "memset failed\n"); return; }
    Args a{};
    for (int i = 0; i < 24; ++i) a.in[i] = (const float*)d_in[i];
    a.out = (float*)d_out; a.ws = (unsigned char*)d_ws;
    void* args[] = {&a};
    hipError_t e = hipLaunchCooperativeKernel((const void*)mega_fwd, dim3(grid), dim3(NTHR), args, LDS_BYTES, stream);
    if (e != hipSuccess) fprintf(stderr, "cooperative launch failed: %s (grid %d)\n", hipGetErrorString(e), grid);
}
```

```cpp
#include <hip/hip_runtime.h>
#include <hip/hip_cooperative_groups.h>
#include <cstdio>
#include <cstdint>
namespace cg = cooperative_groups;
namespace pg8 {
#define PG8_LAS __attribute__((address_space(3)))
typedef unsigned short bf16_t;
typedef short bf16x8 __attribute__((ext_vector_type(8)));
typedef float f32x4 __attribute__((ext_vector_type(4)));
typedef unsigned u32x4 __attribute__((ext_vector_type(4)));
constexpr int BM = 256, BK = 64, HALF = 128, HTB = HALF * BK * 2  , STAGE_BYTES = 8 * HTB, NXCD = 8, WGM = 8;

__host__ __device__ __forceinline__ int lds_byte(int r, int c) { const int st = (r >> 4) * 2 + (c >> 5), rr = r & 15, cc = c & 31, ob = rr * 64 + cc * 2; return st * 1024 + (ob ^ (((ob >> 9) & 1) << 5)); }
__host__ __device__ __forceinline__ void stage_rc(int b, int& R, int& C) { const int st = b / 1024, sb = b % 1024, swz = sb ^ (((sb >> 9) & 1) << 5); R = (st >> 1) * 16 + swz / 64; C = (st & 1) * 32 + (swz % 64) / 2; }
__host__ __device__ __forceinline__ int perm32(int rho) { const int n = rho >> 4, i = rho & 15; return 8 * (i >> 2) + 4 * n + (i & 3); }

struct Unit { int pm, pn; };
struct Gemm { const bf16_t* A; const bf16_t* Bt; int M, N, K, lda; };

struct StaticOrder {
    int nM, nN, nwg, G, c;
    __host__ __device__ void init(int M, int N, int G_, int c_) { nM = M / BM; nN = N / BM; nwg = nM * nN; G = G_; c = c_; }
    __host__ __device__ bool next(int i, Unit& u) const {
        const long L = (long)i * G + c; if (L >= nwg) return false;
        int wgid = (int)L; { const int q = nwg / NXCD, r = nwg % NXCD, xcd = wgid % NXCD, off = wgid / NXCD; wgid = (xcd < r ? xcd * (q + 1) : r * (q + 1) + (xcd - r) * q) + off; }
        const int nig = WGM * nN, gid = wgid / nig, fm = gid * WGM, gsz = (nM - fm) < WGM ? (nM - fm) : WGM;
        u.pm = fm + ((wgid % nig) % gsz); u.pn = (wgid % nig) / gsz; return true;
    }
    __device__ __forceinline__ void a_ready(const Unit&) const {}
    __device__ __forceinline__ void done(const Unit&) const {}
};

typedef float f32x2_t __attribute__((ext_vector_type(2))); typedef __bf16 bf16x2_t __attribute__((ext_vector_type(2)));
__device__ __forceinline__ unsigned cvtpk(float lo, float hi) { f32x2_t v = {lo, hi}; bf16x2_t b = __builtin_convertvector(v, bf16x2_t); return __builtin_bit_cast(unsigned, b); }
__device__ __forceinline__ float bflo(unsigned w) { return __uint_as_float(w << 16); }
__device__ __forceinline__ float bfhi(unsigned w) { return __uint_as_float(w & 0xffff0000u); }
__device__ __forceinline__ float sigmoidf_(float x) { return __builtin_amdgcn_rcpf(1.0f + __builtin_amdgcn_exp2f(-1.4426950408889634f * x)); }
__device__ __forceinline__ float siluf_(float x) { return x * sigmoidf_(x); }

struct EpiSwiGLU {
    static constexpr bool PERM = true, AFTER_DRAIN = false, HAS_MID = false; int mid_t;
    bf16_t* O; int ldc;
    __device__ __forceinline__ void mid(f32x4 (&)[2][2][4][2], const Unit&, int, int, int, int) const {}
    __device__ __forceinline__ void operator()(const f32x4 (&acc)[2][2][4][2], const Unit& u, int wr, int wc, int fr, int fq) const {
        const int row0 = u.pm * BM + wr * 64 + fr, col0 = u.pn * HALF + wc * 32 + 8 * fq;
#pragma unroll
        for (int ai = 0; ai < 2; ++ai)
#pragma unroll
            for (int m = 0; m < 4; ++m) { bf16_t* rowp = O + (size_t)(row0 + ai * HALF + m * 16) * ldc + col0;
                const f32x4 g0 = acc[ai][0][m][0], g1 = acc[ai][0][m][1], u0 = acc[ai][1][m][0], u1 = acc[ai][1][m][1];
                u32x4 w; w.x = cvtpk(siluf_(g0[0]) * u0[0], siluf_(g0[1]) * u0[1]); w.y = cvtpk(siluf_(g0[2]) * u0[2], siluf_(g0[3]) * u0[3]);
                w.z = cvtpk(siluf_(g1[0]) * u1[0], siluf_(g1[1]) * u1[1]); w.w = cvtpk(siluf_(g1[2]) * u1[2], siluf_(g1[3]) * u1[3]);
                *(u32x4*)rowp = w; }
    }
};
struct EpiResid {
    static constexpr bool PERM = false, AFTER_DRAIN = false, HAS_MID = false; int mid_t;
    const float* res; float* out; int ldc; float alpha, s;
    __device__ __forceinline__ void mid(f32x4 (&)[2][2][4][2], const Unit&, int, int, int, int) const {}
    __device__ __forceinline__ void operator()(const f32x4 (&acc)[2][2][4][2], const Unit& u, int wr, int wc, int fr, int fq) const {
        const int row0 = u.pm * BM + wr * 64 + fr, col0 = u.pn * BM + wc * 32 + 4 * fq;
#pragma unroll
        for (int ai = 0; ai < 2; ++ai)
#pragma unroll
            for (int m = 0; m < 4; ++m) { const size_t off = (size_t)(row0 + ai * HALF + m * 16) * ldc + col0;
#pragma unroll
                for (int bj = 0; bj < 2; ++bj)
#pragma unroll
                    for (int n = 0; n < 2; ++n) { const f32x4 r = *(const f32x4*)(res + off + bj * HALF + n * 16); *(f32x4*)(out + off + bj * HALF + n * 16) = r * alpha + acc[ai][bj][m][n] * s; } }
    }
};
struct EpiInProj {
    static constexpr bool PERM = true, AFTER_DRAIN = false, HAS_MID = false; int mid_t;
    bf16_t* O; int ldc; float* dt;
    __device__ __forceinline__ void mid(f32x4 (&)[2][2][4][2], const Unit&, int, int, int, int) const {}
    __device__ __forceinline__ void operator()(const f32x4 (&acc)[2][2][4][2], const Unit& u, int wr, int wc, int fr, int fq) const {
        const int row0 = u.pm * BM + wr * 64 + fr;
        if (u.pn == 34) {
            if (wc == 0) {
#pragma unroll
                for (int ai = 0; ai < 2; ++ai)
#pragma unroll
                    for (int m = 0; m < 4; ++m) { float* p = dt + (size_t)(row0 + ai * HALF + m * 16) * 32 + 8 * fq; *(f32x4*)p = acc[ai][0][m][0]; *(f32x4*)(p + 4) = acc[ai][0][m][1]; }
            }
            return;
        }
        const bool gate = u.pn >= 26; const int col0 = u.pn * BM + wc * 32 + 8 * fq;
#pragma unroll
        for (int ai = 0; ai < 2; ++ai)
#pragma unroll
            for (int m = 0; m < 4; ++m) { bf16_t* rowp = O + (size_t)(row0 + ai * HALF + m * 16) * ldc + col0;
#pragma unroll
                for (int bj = 0; bj < 2; ++bj) { f32x4 v0 = acc[ai][bj][m][0], v1 = acc[ai][bj][m][1];
                    if (gate) {
#pragma unroll
                        for (int i = 0; i < 4; ++i) { v0[i] = sigmoidf_(v0[i]); v1[i] = sigmoidf_(v1[i]); } }
                    u32x4 w; w.x = cvtpk(v0[0], v0[1]); w.y = cvtpk(v0[2], v0[3]); w.z = cvtpk(v1[0], v1[1]); w.w = cvtpk(v1[2], v1[3]);
                    *(u32x4*)(rowp + bj * HALF) = w; } }
    }
};
template <int MODE> struct EpiGate {
    static constexpr bool PERM = true, AFTER_DRAIN = false, HAS_MID = false; int mid_t;
    bf16_t* G; int ldc; int gsoff; bf16_t* O2; int ldo;
    __device__ __forceinline__ void mid(f32x4 (&)[2][2][4][2], const Unit&, int, int, int, int) const {}
    __device__ __forceinline__ void operator()(const f32x4 (&acc)[2][2][4][2], const Unit& u, int wr, int wc, int fr, int fq) const {
        const int row0 = u.pm * BM + wr * 64 + fr, col0 = u.pn * BM + wc * 32 + 8 * fq;
#pragma unroll
        for (int ai = 0; ai < 2; ++ai)
#pragma unroll
            for (int m = 0; m < 4; ++m) { bf16_t* rowp = G + (size_t)(row0 + ai * HALF + m * 16) * ldc + col0; bf16_t* orow = (MODE == 0) ? rowp : O2 + (size_t)(row0 + ai * HALF + m * 16) * ldo + col0;
#pragma unroll
                for (int bj = 0; bj < 2; ++bj) { const u32x4 t = *(const u32x4*)(rowp + bj * HALF); const f32x4 v0 = acc[ai][bj][m][0], v1 = acc[ai][bj][m][1]; u32x4 w;
                    if (MODE == 0) { w.x = cvtpk(v0[0] * bflo(t.x), v0[1] * bfhi(t.x)); w.y = cvtpk(v0[2] * bflo(t.y), v0[3] * bfhi(t.y));
                        w.z = cvtpk(v1[0] * bflo(t.z), v1[1] * bfhi(t.z)); w.w = cvtpk(v1[2] * bflo(t.w), v1[3] * bfhi(t.w)); }
                    else { const u32x4 s = *(const u32x4*)(rowp + bj * HALF + gsoff);
                        w.x = cvtpk(bflo(t.x) + v0[0] * bflo(s.x), bfhi(t.x) + v0[1] * bfhi(s.x)); w.y = cvtpk(bflo(t.y) + v0[2] * bflo(s.y), bfhi(t.y) + v0[3] * bfhi(s.y));
                        w.z = cvtpk(bflo(t.z) + v1[0] * bflo(s.z), bfhi(t.z) + v1[1] * bfhi(s.z)); w.w = cvtpk(bflo(t.w) + v1[2] * bflo(s.w), bfhi(t.w) + v1[3] * bfhi(s.w)); }
                    *(u32x4*)(orow + bj * HALF) = w; } }
    }
};
template <class Epi, class Sched, bool ALIGN_EPI = false, bool SP2 = false>
__device__ __forceinline__ void gemm_phase(PG8_LAS unsigned char* lds, const Gemm g, const Sched& S, const Epi& E) {
    int tid_ = threadIdx.x; asm volatile("" : "+v"(tid_)); const int tid = tid_, wid = __builtin_amdgcn_readfirstlane(tid >> 6), lane = tid & 63, wr = wid >> 2, wc = wid & 3, fr = lane & 15, fq = lane >> 4;
    const int K = g.K, nt = K / BK;
    unsigned voffA[2], voffB[2];
#pragma unroll
    for (int i = 0; i < 2; ++i) { int R, C; stage_rc(tid * 16 + i * 8192, R, C); const int Rb = Epi::PERM ? ((R & ~31) + perm32(R & 31)) : R;
        voffA[i] = (unsigned)(R * g.lda + C) * 2u; voffB[i] = (unsigned)(Rb * K + C) * 2u; }
    const size_t kstep = (size_t)(BK * 2);
    const size_t hstepB = (size_t)HALF * K * 2, hstepA = (size_t)HALF * g.lda * 2;
    const size_t tstepA = 2 * hstepA, tstepB = 2 * hstepB;
    const unsigned ldsw = (unsigned)wid * 1024u;
    const int aoff = lds_byte(wr * 64 + fr, fq * 8), boff = lds_byte(wc * 32 + fr, fq * 8);
#define PG8_SA(b, h) (((b) * 2 + (h)) * HTB)
#define PG8_SB(b, h) ((4 + (b) * 2 + (h)) * HTB)
#define PG8_STAGE(bufoff, gbase, voff) do { _Pragma("unroll") for (int _i = 0; _i < 2; ++_i) \
        __builtin_amdgcn_global_load_lds((const unsigned*)((const char*)(gbase) + (voff)[_i]), (PG8_LAS unsigned*)(lds + (bufoff) + ldsw + _i * 8192), 16, 0, 0); } while (0)
#define PG8_LDA(dst, b, h) do { _Pragma("unroll") for (int m = 0; m < 4; ++m) _Pragma("unroll") for (int k = 0; k < 2; ++k) dst[m][k] = *(const PG8_LAS bf16x8*)(lds + PG8_SA(b, h) + aoff + m * 2048 + k * 1024); } while (0)
#define PG8_LDB(dst, b, h) do { _Pragma("unroll") for (int n = 0; n < 2; ++n) _Pragma("unroll") for (int k = 0; k < 2; ++k) dst[n][k] = *(const PG8_LAS bf16x8*)(lds + PG8_SB(b, h) + boff + n * 2048 + k * 1024); } while (0)
#define PG8_MMA(ai, bj, At, Bt) do { __builtin_amdgcn_s_setprio(1); _Pragma("unroll") for (int m = 0; m < 4; ++m) _Pragma("unroll") for (int n = 0; n < 2; ++n) _Pragma("unroll") for (int k = 0; k < 2; ++k) \
        acc[ai][bj][m][n] = __builtin_amdgcn_mfma_f32_16x16x32_bf16(Bt[n][k], At[m][k], acc[ai][bj][m][n], 0, 0, 0); __builtin_amdgcn_s_setprio(0); } while (0)
#define PG8_WAIT_V(n) asm volatile("s_waitcnt vmcnt(" #n ")" ::: "memory")
#define PG8_WAIT_L(n) asm volatile("s_waitcnt lgkmcnt(" #n ")" ::: "memory")
#define PG8_BAR __builtin_amdgcn_s_barrier()
#define PG8_SCHED __builtin_amdgcn_sched_barrier(0)
    Unit cur, nxt; int ui = 0;
    if (!S.next(0, cur)) return;
    f32x4 acc[2][2][4][2];
#pragma unroll
    for (int a = 0; a < 2; ++a)
#pragma unroll
        for (int b = 0; b < 2; ++b)
#pragma unroll
            for (int m = 0; m < 4; ++m)
#pragma unroll
                for (int n = 0; n < 2; ++n) acc[a][b][m][n] = (f32x4){0.f, 0.f, 0.f, 0.f};
    bf16x8 At[4][2], B0[2][2], B1[2][2];
    const char* cA = (const char*)g.A + (size_t)cur.pm * tstepA; const char* cB = (const char*)g.Bt + (size_t)cur.pn * tstepB;
    S.a_ready(cur);
    if constexpr (SP2) {
        PG8_STAGE(PG8_SB(0, 0), cB, voffB); PG8_STAGE(PG8_SB(0, 1), cB + hstepB, voffB); PG8_STAGE(PG8_SA(0, 0), cA, voffA); PG8_STAGE(PG8_SA(0, 1), cA + hstepA, voffA);
        if (wr == 1) PG8_BAR;
        PG8_WAIT_V(2); PG8_BAR;
        PG8_STAGE(PG8_SB(1, 0), cB + kstep, voffB); PG8_STAGE(PG8_SA(1, 0), cA + kstep, voffA); PG8_STAGE(PG8_SB(1, 1), cB + hstepB + kstep, voffB);
        PG8_WAIT_V(6); PG8_BAR;
    } else {
        PG8_STAGE(PG8_SB(0, 0), cB, voffB); PG8_STAGE(PG8_SA(0, 0), cA, voffA); PG8_STAGE(PG8_SB(0, 1), cB + hstepB, voffB); PG8_STAGE(PG8_SA(0, 1), cA + hstepA, voffA);
        if (wr == 1) PG8_BAR;
        PG8_WAIT_V(4); PG8_BAR;
        PG8_STAGE(PG8_SB(1, 0), cB + kstep, voffB); PG8_STAGE(PG8_SA(1, 0), cA + kstep, voffA); PG8_STAGE(PG8_SB(1, 1), cB + hstepB + kstep, voffB);
        PG8_WAIT_V(6); PG8_BAR;
    }
    for (;;) {
        const bool has_next = S.next(ui + 1, nxt);
        const char* nA = has_next ? (const char*)g.A + (size_t)nxt.pm * tstepA : cA; const char* nB = has_next ? (const char*)g.Bt + (size_t)nxt.pn * tstepB : cB;
        for (int t = 0; t < nt; t += 2) {
            if constexpr (Epi::HAS_MID) { if (t == E.mid_t) E.mid(acc, cur, wr, wc, fr, fq); }
            const bool last = (t == nt - 2);
            const char* a1 = cA + (size_t)(t + 1) * kstep;
            const char* a2 = last ? nA : cA + (size_t)(t + 2) * kstep; const char* b2 = last ? nB : cB + (size_t)(t + 2) * kstep;
            const char* a3 = a2 + kstep; const char* b3 = b2 + kstep;
            if (last && has_next) S.a_ready(nxt);
            if constexpr (SP2) {
            PG8_LDB(B0, 0, 0); PG8_LDB(B1, 0, 1); PG8_SCHED; PG8_LDA(At, 0, 0); PG8_STAGE(PG8_SA(1, 1), a1 + hstepA, voffA);
            PG8_WAIT_V(8); PG8_WAIT_L(0); PG8_BAR; PG8_MMA(0, 0, At, B0); PG8_MMA(0, 1, At, B1); PG8_BAR; PG8_SCHED;
            PG8_LDA(At, 0, 1); PG8_STAGE(PG8_SB(0, 0), b2, voffB); PG8_STAGE(PG8_SB(0, 1), b2 + hstepB, voffB); PG8_STAGE(PG8_SA(0, 0), a2, voffA);
            PG8_WAIT_V(8); PG8_WAIT_L(0); PG8_BAR; PG8_MMA(1, 0, At, B0); PG8_MMA(1, 1, At, B1); PG8_BAR; PG8_SCHED;
            PG8_LDB(B0, 1, 0); PG8_LDB(B1, 1, 1); PG8_SCHED; PG8_LDA(At, 1, 0); PG8_STAGE(PG8_SA(0, 1), a2 + hstepA, voffA);
            PG8_WAIT_V(8); PG8_WAIT_L(0); PG8_BAR; PG8_MMA(0, 0, At, B0); PG8_MMA(0, 1, At, B1); PG8_BAR; PG8_SCHED;
            PG8_LDA(At, 1, 1); PG8_STAGE(PG8_SB(1, 0), b3, voffB); PG8_STAGE(PG8_SB(1, 1), b3 + hstepB, voffB); PG8_STAGE(PG8_SA(1, 0), a3, voffA);
            PG8_WAIT_V(8); PG8_WAIT_L(0); PG8_BAR; PG8_MMA(1, 0, At, B0); PG8_MMA(1, 1, At, B1); PG8_BAR; PG8_SCHED;
            } else {
            PG8_LDB(B0, 0, 0); PG8_SCHED; PG8_LDA(At, 0, 0); PG8_STAGE(PG8_SA(1, 1), a1 + hstepA, voffA);
            PG8_WAIT_L(8); PG8_BAR; PG8_WAIT_L(0); PG8_MMA(0, 0, At, B0); PG8_BAR; PG8_SCHED;
            PG8_LDB(B1, 0, 1); PG8_STAGE(PG8_SB(0, 0), b2, voffB);
            PG8_BAR; PG8_WAIT_L(0); PG8_MMA(0, 1, At, B1); PG8_BAR;
            PG8_LDA(At, 0, 1); PG8_STAGE(PG8_SA(0, 0), a2, voffA);
            PG8_BAR; PG8_WAIT_L(0); PG8_MMA(1, 0, At, B0); PG8_BAR; PG8_SCHED;
            PG8_STAGE(PG8_SB(0, 1), b2 + hstepB, voffB);
            PG8_WAIT_V(6); PG8_BAR; PG8_MMA(1, 1, At, B1); PG8_BAR;
            PG8_LDB(B0, 1, 0); PG8_SCHED; PG8_LDA(At, 1, 0); PG8_STAGE(PG8_SA(0, 1), a2 + hstepA, voffA);
            PG8_WAIT_L(8); PG8_BAR; PG8_WAIT_L(0); PG8_MMA(0, 0, At, B0); PG8_BAR; PG8_SCHED;
            PG8_LDB(B1, 1, 1); PG8_STAGE(PG8_SB(1, 0), b3, voffB);
            PG8_BAR; PG8_WAIT_L(0); PG8_MMA(0, 1, At, B1); PG8_BAR;
            PG8_LDA(At, 1, 1); PG8_STAGE(PG8_SA(1, 0), a3, voffA);
            PG8_BAR; PG8_WAIT_L(0); PG8_MMA(1, 0, At, B0); PG8_BAR; PG8_SCHED;
            PG8_STAGE(PG8_SB(1, 1), b3 + hstepB, voffB);
            PG8_WAIT_V(6); PG8_BAR; PG8_MMA(1, 1, At, B1); PG8_BAR;
            }
        }
        if constexpr (ALIGN_EPI) { if (wr == 0) PG8_BAR; }
        if constexpr (!Epi::AFTER_DRAIN) { E(acc, cur, wr, wc, fr, fq); S.done(cur); }
        if (!has_next) break;
#pragma unroll
        for (int a = 0; a < 2; ++a)
#pragma unroll
            for (int b = 0; b < 2; ++b)
#pragma unroll
                for (int m = 0; m < 4; ++m)
#pragma unroll
                    for (int n = 0; n < 2; ++n) acc[a][b][m][n] = (f32x4){0.f, 0.f, 0.f, 0.f};
        cur = nxt; cA = nA; cB = nB; ++ui;
        if constexpr (ALIGN_EPI) { if (wr == 1) PG8_BAR; }
    }
    PG8_WAIT_V(0);
    if constexpr (!ALIGN_EPI) { if (wr == 0) PG8_BAR; }
    PG8_BAR;
    if constexpr (Epi::AFTER_DRAIN) { E.fused(acc, cur, wr, wc, fr, fq, lds, wid, lane); S.done(cur); }
#undef PG8_SA
#undef PG8_SB
#undef PG8_STAGE
#undef PG8_LDA
#undef PG8_LDB
#undef PG8_MMA
#undef PG8_WAIT_V
#undef PG8_WAIT_L
#undef PG8_BAR
#undef PG8_SCHED
}
}

#define LAS __attribute__((address_space(3)))
typedef unsigned short bf16;
typedef float f32x4 __attribute__((ext_vector_type(4)));
typedef short bf16x8 __attribute__((ext_vector_type(8)));
typedef short bf16x4 __attribute__((ext_vector_type(4)));
typedef unsigned u32x4 __attribute__((ext_vector_type(4)));
typedef unsigned u32x2 __attribute__((ext_vector_type(2)));
using pg8::cvtpk; using pg8::bflo; using pg8::bfhi; using pg8::siluf_; using pg8::sigmoidf_;
constexpr int NWAVES = 8, NTHR = 512;
constexpr int M = 16384, MB = 8192, DMODEL = 1024, DFF = 2816;
constexpr int LDP = 8704;
constexpr int PC_Q = 0, PC_Z = 1024, PC_K = 3072, PC_V = 3328, PC_XBC = 3584, PC_GA = 6656, PC_GS = 7680;
constexpr int NPROJ = 8960;
constexpr float LN_EPS = 1e-5f, RMS_EPS = 1e-5f;
constexpr float ALPHA = 1.189207115002721f;
constexpr size_t MiB = 1u << 20;
constexpr size_t WS_CTL = 0, WS_DEC = 512 * 1024, WS_DT = 1 * MiB, WS_WGU = 2 * MiB, WS_WD = 13 * MiB, WS_WIN = 19 * MiB, WS_WCAT = 37 * MiB, WS_WOUT = 43 * MiB, WS_X1F = 45 * MiB, WS_BIG = 109 * MiB, WS_END = 245 * MiB;
constexpr size_t DO_XB = 0, DO_ST = 32 * MiB;
constexpr int LDS_BYTES = 147456;

#define LDS_WAIT() asm volatile("s_waitcnt lgkmcnt(0)" ::: "memory")
#define MFMA16(a, b, c) __builtin_amdgcn_mfma_f32_16x16x32_bf16((a), (b), (c), 0, 0, 0)

__device__ __forceinline__ float wave_sum(float v) {
#pragma unroll
    for (int o = 1; o < 64; o <<= 1) v += __shfl_xor(v, o);
    return v;
}
__device__ __forceinline__ void tr_item(const float* W, int ldw, int k0, int n0, bf16* WT, int ldt, int drow, int dcol, LAS float* scr, int lane) {
#pragma unroll 8
    for (int i = 0; i < 32; ++i) { const int kk = 2 * i + (lane >> 5); scr[kk * 33 + (lane & 31)] = W[(size_t)(k0 + kk) * ldw + n0 + (lane & 31)]; }
    LDS_WAIT(); asm volatile("" ::: "memory");
    const int c = lane & 7;
#pragma unroll
    for (int j = 0; j < 4; ++j) { const int n = (lane >> 3) + 8 * j; const LAS float* s = scr + (8 * c) * 33 + n;
        u32x4 o; o.x = cvtpk(s[0 * 33], s[1 * 33]); o.y = cvtpk(s[2 * 33], s[3 * 33]); o.z = cvtpk(s[4 * 33], s[5 * 33]); o.w = cvtpk(s[6 * 33], s[7 * 33]);
        *(u32x4*)(WT + (size_t)(drow + n) * ldt + dcol + 8 * c) = o; }
    LDS_WAIT(); asm volatile("" ::: "memory");
}
__device__ __forceinline__ int map_in(int n0) {
    if (n0 < 1024) return n0;
    if (n0 < 1280) return PC_K + (n0 - 1024);
    if (n0 < 1536) return PC_V + (n0 - 1280);
    if (n0 < 3584) return PC_Z + (n0 - 1536);
    if (n0 < 6656) return n0;
    if (n0 < 6688) return 8704 + (n0 - 6656);
    if (n0 < 7712) return PC_GA + (n0 - 6688);
    return PC_GS + (n0 - 7712);
}
__device__ __forceinline__ void ffn_weight_items(const float* wg, const float* wu, const float* wd, bf16* Wgu, bf16* Wd, LAS float* scr, int gw, int NGW, int lane) {
    constexpr int I_G = 16 * 88, I_D = 44 * 32;
    for (int it = gw; it < 2 * I_G + I_D; it += NGW) {
        int r = it;
        if (r < 2 * I_G) { const bool up = r >= I_G; if (up) r -= I_G; const int kb = r / 88, nb = r % 88, n0 = nb * 32;
            tr_item(up ? wu : wg, DFF, kb * 64, n0, Wgu, 1024, (n0 >> 7) * 256 + (n0 & 127) + (up ? 128 : 0), kb * 64, scr, lane); continue; }
        r -= 2 * I_G; { const int kb = r / 32, nb = r % 32; tr_item(wd, 1024, kb * 64, nb * 32, Wd, DFF, nb * 32, kb * 64, scr, lane); }
    }
}
__device__ __forceinline__ void ln_rows(const float* src, float* dstf, bf16* dstb, const float* g, const float* b, int nrows, int gw, int NGW, int lane) {
    f32x4 gv[4], bv[4];
#pragma unroll
    for (int j = 0; j < 4; ++j) { gv[j] = *((const f32x4*)g + lane + 64 * j); bv[j] = *((const f32x4*)b + lane + 64 * j); }
    for (int m = gw; m < nrows; m += NGW) {
        const f32x4* xr = (const f32x4*)(src + (size_t)m * 1024) + lane;
        f32x4 v[4]; float s = 0.f;
#pragma unroll
        for (int j = 0; j < 4; ++j) { v[j] = xr[64 * j]; s += (v[j].x + v[j].y) + (v[j].z + v[j].w); }
        const float mean = wave_sum(s) * (1.f / 1024.f); float s2 = 0.f;
#pragma unroll
        for (int j = 0; j < 4; ++j) { v[j] = v[j] - mean; s2 += (v[j].x * v[j].x + v[j].y * v[j].y) + (v[j].z * v[j].z + v[j].w * v[j].w); }
        const float rstd = 1.f / sqrtf(wave_sum(s2) * (1.f / 1024.f) + LN_EPS);
#pragma unroll
        for (int j = 0; j < 4; ++j) { const f32x4 y = v[j] * rstd * gv[j] + bv[j];
            if (dstf) *((f32x4*)(dstf + (size_t)m * 1024) + lane + 64 * j) = y;
            if (dstb) { u32x2 w; w.x = cvtpk(y.x, y.y); w.y = cvtpk(y.z, y.w); *((u32x2*)(dstb + (size_t)m * 1024) + lane + 64 * j) = w; } }
    }
}
struct ConvW { f32x4 w[4][2]; f32x4 b[2]; };
__device__ __forceinline__ void conv_load_w(ConvW& cw, const float* conv_w, const float* conv_b, int xch) {
#pragma unroll
    for (int j = 0; j < 4; ++j) { cw.w[j][0] = *(const f32x4*)(conv_w + j * 3072 + xch); cw.w[j][1] = *(const f32x4*)(conv_w + j * 3072 + xch + 4); }
    cw.b[0] = *(const f32x4*)(conv_b + xch); cw.b[1] = *(const f32x4*)(conv_b + xch + 4);
}
__device__ __forceinline__ void conv8(const bf16* P, int row, int xch, const ConvW& cw, float (&o)[8]) {
    f32x4 a0 = cw.b[0], a1 = cw.b[1];
#pragma unroll
    for (int j = 0; j < 4; ++j) { const int r = row - 3 + j;
        if (r >= 0) { const u32x4 v = *(const u32x4*)(P + (size_t)r * LDP + PC_XBC + xch);
            a0[0] += cw.w[j][0][0] * bflo(v.x); a0[1] += cw.w[j][0][1] * bfhi(v.x); a0[2] += cw.w[j][0][2] * bflo(v.y); a0[3] += cw.w[j][0][3] * bfhi(v.y);
            a1[0] += cw.w[j][1][0] * bflo(v.z); a1[1] += cw.w[j][1][1] * bfhi(v.z); a1[2] += cw.w[j][1][2] * bflo(v.w); a1[3] += cw.w[j][1][3] * bfhi(v.w); } }
#pragma unroll
    for (int i = 0; i < 4; ++i) { o[i] = siluf_(a0[i]); o[4 + i] = siluf_(a1[i]); }
}
template <bool TR> __device__ __forceinline__ void conv_tile8(LAS unsigned char* dst, const bf16* P, int row0, int xch, int cgl, int lr,
                                                           const float* conv_w, const float* conv_b, const LAS float* sw) {
    ConvW cw; conv_load_w(cw, conv_w, conv_b, xch);
    u32x4 raw[11];
#pragma unroll
    for (int k = 0; k < 11; ++k) { const int r = row0 + lr * 8 - 3 + k; raw[k] = (r >= 0) ? *(const u32x4*)(P + (size_t)r * LDP + PC_XBC + xch) : (u32x4){0u, 0u, 0u, 0u}; }
    unsigned pk[8][2];
#pragma unroll
    for (int lp = 0; lp < 4; ++lp) { float o[2][8];
#pragma unroll
        for (int q = 0; q < 2; ++q) { f32x4 a0 = cw.b[0], a1 = cw.b[1];
#pragma unroll
            for (int j = 0; j < 4; ++j) { const u32x4 v = raw[2 * lp + q + j];
                a0[0] += cw.w[j][0][0] * bflo(v.x); a0[1] += cw.w[j][0][1] * bfhi(v.x); a0[2] += cw.w[j][0][2] * bflo(v.y); a0[3] += cw.w[j][0][3] * bfhi(v.y);
                a1[0] += cw.w[j][1][0] * bflo(v.z); a1[1] += cw.w[j][1][1] * bfhi(v.z); a1[2] += cw.w[j][1][2] * bflo(v.w); a1[3] += cw.w[j][1][3] * bfhi(v.w); }
            const float sc = sw ? sw[lr * 8 + 2 * lp + q] : 1.0f;
#pragma unroll
            for (int i = 0; i < 4; ++i) { o[q][i] = siluf_(a0[i]) * sc; o[q][4 + i] = siluf_(a1[i]) * sc; } }
        if (TR) {
#pragma unroll
            for (int e = 0; e < 8; ++e) pk[e][lp & 1] = cvtpk(o[0][e], o[1][e]);
            if (lp & 1) {
#pragma unroll
                for (int e = 0; e < 8; ++e) *(LAS u32x2*)(dst + (cgl * 8 + e) * 272 + lr * 16 + (lp >> 1) * 8) = (u32x2){pk[e][0], pk[e][1]}; }
        } else {
#pragma unroll
            for (int q = 0; q < 2; ++q) { u32x4 pw; pw.x = cvtpk(o[q][0], o[q][1]); pw.y = cvtpk(o[q][2], o[q][3]); pw.z = cvtpk(o[q][4], o[q][5]); pw.w = cvtpk(o[q][6], o[q][7]);
                *(LAS u32x4*)(dst + (lr * 8 + 2 * lp + q) * 272 + cgl * 16) = pw; } } }
}
__device__ __forceinline__ void chunk_decay(const float* dtbuf, int row0, int head, float bias, float Aneg, int lane, float& dt0, float& dt1, float& ac0, float& ac1) {
    float r0 = dtbuf[(size_t)(row0 + 2 * lane) * 32 + head] + bias, r1 = dtbuf[(size_t)(row0 + 2 * lane + 1) * 32 + head] + bias;
    dt0 = fmaxf(r0, 0.f) + log1pf(__expf(-fabsf(r0))); dt1 = fmaxf(r1, 0.f) + log1pf(__expf(-fabsf(r1)));
    const float a0 = dt0 * Aneg, a1 = dt1 * Aneg;
    float s = a0 + a1;
#pragma unroll
    for (int o = 1; o < 64; o <<= 1) { const float t = __shfl_up(s, o); if (lane >= o) s += t; }
    ac1 = s; ac0 = s - a1;
}

#define XB_TMO      128
#define XB_XCNT(j)  (256  + 64 * (j))
#define XB_XSUB(j)  (1280 + 64 * (j))
#define XB_XGEN(j)  (2304 + 64 * (j))
#define XB_TOP      3328
#define XB_TOPGEN   3392
#define XCD_BAR_WORDS 3456
#define XB_SPIN_CAP (1u << 18)

__device__ __forceinline__ unsigned xb_ld(unsigned* p)              { return __hip_atomic_load(p, __ATOMIC_RELAXED, __HIP_MEMORY_SCOPE_AGENT); }
__device__ __forceinline__ unsigned xb_add(unsigned* p, unsigned v) { return __hip_atomic_fetch_add(p, v, __ATOMIC_RELAXED, __HIP_MEMORY_SCOPE_AGENT); }
__device__ __forceinline__ unsigned xb_xcc_id() { return (unsigned)__builtin_amdgcn_s_getreg((3 << 11) | 20) & 0xFu; }
#define XB_SPIN(cond, bar) do { unsigned _sp = 0; while (cond) { __builtin_amdgcn_s_sleep(1); \
    if ((++_sp & 255u) == 0u) { if (xb_ld(&(bar)[XB_TMO])) break; if (_sp > XB_SPIN_CAP) { atomicAdd(&(bar)[XB_TMO], 1u); break; } } } } while (0)

struct XcdBarrier {
    unsigned* bar; unsigned x;
    volatile LAS unsigned* st;
};

__device__ __forceinline__ XcdBarrier xcd_barrier_post(unsigned* bar, volatile LAS unsigned* st) {
    XcdBarrier b; b.bar = bar; b.x = xb_xcc_id(); b.st = st;
    if (threadIdx.x == 0) (void)xb_add(&bar[XB_XCNT(b.x)], 1u);
    return b;
}
__device__ __forceinline__ void xcd_barrier_complete(unsigned* bar, unsigned x, unsigned& nloc, unsigned& nx) {
    const unsigned G = gridDim.x * gridDim.y * gridDim.z;
    unsigned sum, cnt, mine, sp = 0u;
    for (;;) {
        sum = 0u; cnt = 0u; mine = 0u;
#pragma unroll
        for (unsigned j = 0; j < 16; ++j) { const unsigned c = xb_ld(&bar[XB_XCNT(j)]); sum += c; cnt += (c > 0u) ? 1u : 0u; mine = (j == x) ? c : mine; }
        if (sum == G) break;
        __builtin_amdgcn_s_sleep(1);
        if ((++sp & 255u) == 0u) { if (xb_ld(&bar[XB_TMO])) break; if (sp > XB_SPIN_CAP) { atomicAdd(&bar[XB_TMO], 1u); break; } }
    }
    nloc = mine > 0u ? mine : 1u; nx = cnt > 0u ? cnt : 1u;
}

__device__ __forceinline__ void xcd_barrier(const XcdBarrier& b) {
    asm volatile("s_waitcnt vmcnt(0)" ::: "memory");
    __syncthreads();
    if (threadIdx.x == 0) {
        unsigned* bar = b.bar;
        __builtin_amdgcn_s_waitcnt(0);
        unsigned nloc = b.st[0], nx = b.st[1];
        if (nloc == 0u) { xcd_barrier_complete(bar, b.x, nloc, nx); b.st[0] = nloc; b.st[1] = nx; }
        const unsigned old = xb_add(&bar[XB_XSUB(b.x)], 1u);
        const unsigned gen = old / nloc;
        if (old + 1u == (gen + 1u) * nloc) {
            __builtin_amdgcn_fence(__ATOMIC_RELEASE, "agent");
            asm volatile("s_waitcnt vmcnt(0)" ::: "memory");
            const unsigned og = xb_add(&bar[XB_TOP], 1u);
            const unsigned tg = og / nx;
            if (og + 1u == (tg + 1u) * nx) xb_add(&bar[XB_TOPGEN], 1u);
            else XB_SPIN(xb_ld(&bar[XB_TOPGEN]) == tg, bar);
            __builtin_amdgcn_fence(__ATOMIC_ACQUIRE, "agent");
            xb_add(&bar[XB_XGEN(b.x)], 1u);
            asm volatile("s_waitcnt vmcnt(0)" ::: "memory");
        } else {
            XB_SPIN(xb_ld(&bar[XB_XGEN(b.x)]) == gen, bar);
            __builtin_amdgcn_fence(__ATOMIC_ACQUIRE, "agent");
            asm volatile("s_waitcnt vmcnt(0)" ::: "memory");
        }
    }
    __syncthreads();
}

constexpr int AT_QS = 0, AT_KS = 18432, AT_VT = 55296, AT_PS = 91136, AT_END = AT_PS + 8 * 16 * 336;
static_assert(AT_END <= 147456, "attention LDS");
__device__ __forceinline__ void attn_unit(LAS unsigned char* lds, bf16* P, int blk, int h, float sink, int tid_in) {
    int tid = tid_in; asm volatile("" : "+v"(tid));
    const int lane = tid & 63, w = __builtin_amdgcn_readfirstlane(tid >> 6), fr = lane & 15, kg = lane >> 4;
    const int row0 = blk * 128, g = h >> 2;
#pragma unroll
    for (int i = 0; i < 2; ++i) { const int idx = tid + 512 * i, r = idx >> 3, ch = idx & 7;
        const u32x4 v = *(const u32x4*)(P + (size_t)(row0 + r) * LDP + PC_Q + h * 64 + ch * 8); *(LAS u32x4*)(lds + AT_QS + r * 144 + ch * 16) = v; }
#pragma unroll
    for (int i = 0; i < 4; ++i) { const int idx = tid + 512 * i, kj = idx >> 3, ch = idx & 7; const int srow = (blk > 0) ? row0 - 128 + kj : row0 + (kj & 127);
        const u32x4 v = *(const u32x4*)(P + (size_t)srow * LDP + PC_K + g * 64 + ch * 8); *(LAS u32x4*)(lds + AT_KS + kj * 144 + ch * 16) = v; }
#pragma unroll
    for (int i = 0; i < 4; ++i) { const int idx = tid + 512 * i, kj = idx & 255, ch = idx >> 8; const int srow = (blk > 0) ? row0 - 128 + kj : row0 + (kj & 127);
        const u32x4 v = *(const u32x4*)(P + (size_t)srow * LDP + PC_V + g * 64 + ch * 8);
        LAS unsigned short* d = (LAS unsigned short*)(lds + AT_VT + (ch * 8) * 560 + kj * 2);
        d[0 * 280] = (unsigned short)(v.x & 0xffffu); d[1 * 280] = (unsigned short)(v.x >> 16); d[2 * 280] = (unsigned short)(v.y & 0xffffu); d[3 * 280] = (unsigned short)(v.y >> 16);
        d[4 * 280] = (unsigned short)(v.z & 0xffffu); d[5 * 280] = (unsigned short)(v.z >> 16); d[6 * 280] = (unsigned short)(v.w & 0xffffu); d[7 * 280] = (unsigned short)(v.w >> 16); }
    for (int idx = tid; idx < 64 * 12; idx += 512) { const int d = idx / 12, wv = idx % 12; *(LAS unsigned*)(lds + AT_VT + d * 560 + 512 + wv * 4) = 0u; }
    { const int row = lane >> 2, part = lane & 3; *(LAS u32x2*)(lds + AT_PS + w * 5376 + row * 336 + 288 + part * 8) = (u32x2){0u, 0u}; }
    __syncthreads();
    bf16x8 qf[2];
#pragma unroll
    for (int ks = 0; ks < 2; ++ks) qf[ks] = *(const LAS bf16x8*)(lds + AT_QS + (16 * w + fr) * 144 + (32 * ks + 8 * kg) * 2);
    f32x4 s[9];
#pragma unroll
    for (int ti = 0; ti < 9; ++ti) { const int t = w + ti; f32x4 acc = {0.f, 0.f, 0.f, 0.f};
#pragma unroll
        for (int ks = 0; ks < 2; ++ks) { const bf16x8 kf = *(const LAS bf16x8*)(lds + AT_KS + (16 * t + fr) * 144 + (32 * ks + 8 * kg) * 2); acc = MFMA16(kf, qf[ks], acc); }
        s[ti] = acc; }
    const int qi = 128 + 16 * w + fr; float mx = sink;
#pragma unroll
    for (int ti = 0; ti < 9; ++ti)
#pragma unroll
        for (int j = 0; j < 4; ++j) { const int kj = 16 * (w + ti) + 4 * kg + j, d = qi - kj; const bool valid = (d >= 0) && (d < 128) && (blk > 0 || kj >= 128);
            const float v = valid ? s[ti][j] * 0.125f : -INFINITY; s[ti][j] = v; mx = fmaxf(mx, v); }
    mx = fmaxf(mx, __shfl_xor(mx, 16)); mx = fmaxf(mx, __shfl_xor(mx, 32));
    float sum = 0.f;
#pragma unroll
    for (int ti = 0; ti < 9; ++ti) {
#pragma unroll
        for (int j = 0; j < 4; ++j) { const float p = __expf(s[ti][j] - mx); s[ti][j] = p; sum += p; }
        u32x2 pw; pw.x = cvtpk(s[ti][0], s[ti][1]); pw.y = cvtpk(s[ti][2], s[ti][3]);
        *(LAS u32x2*)(lds + AT_PS + w * 5376 + fr * 336 + (16 * ti + 4 * kg) * 2) = pw; }
    sum += __shfl_xor(sum, 16); sum += __shfl_xor(sum, 32);
    const float inv = 1.0f / (sum + __expf(sink - mx));
    LDS_WAIT(); asm volatile("" ::: "memory");
    f32x4 o[4];
#pragma unroll
    for (int dt = 0; dt < 4; ++dt) o[dt] = (f32x4){0.f, 0.f, 0.f, 0.f};
#pragma unroll
    for (int ks = 0; ks < 5; ++ks) { const bf16x8 pf = *(const LAS bf16x8*)(lds + AT_PS + w * 5376 + fr * 336 + (32 * ks + 8 * kg) * 2);
#pragma unroll
        for (int dt = 0; dt < 4; ++dt) { const bf16x8 vf = *(const LAS bf16x8*)(lds + AT_VT + (16 * dt + fr) * 560 + (16 * w + 32 * ks + 8 * kg) * 2); o[dt] = MFMA16(vf, pf, o[dt]); } }
    bf16* orow = P + (size_t)(row0 + 16 * w + fr) * LDP + PC_Q + h * 64 + 4 * kg;
#pragma unroll
    for (int dt = 0; dt < 4; ++dt) { u32x2 ow; ow.x = cvtpk(o[dt][0] * inv, o[dt][1] * inv); ow.y = cvtpk(o[dt][2] * inv, o[dt][3] * inv); *(u32x2*)(orow + 16 * dt) = ow; }
    __syncthreads();
}

constexpr int S1_BT = 0, S1_XW = 34816, S1_SW = 104448;
__device__ __forceinline__ void s1_unit(LAS unsigned char* lds, const bf16* P, const float* dtbuf, float* dec, bf16* states, int c, int g,
                                        const float* conv_w, const float* conv_b, const float* dt_bias, const float* a_log, int tid_in) {
    int tid = tid_in; asm volatile("" : "+v"(tid));
    const int lane = tid & 63, w = __builtin_amdgcn_readfirstlane(tid >> 6), fr = lane & 15, kg = lane >> 4;
    const int row0 = c * 128;
    { const int hh = 8 * g + w; const float Aneg = -__expf(a_log[hh]); float dt0, dt1, ac0, ac1;
      chunk_decay(dtbuf, row0, hh, dt_bias[hh], Aneg, lane, dt0, dt1, ac0, ac1);
      const float tot = __shfl(ac1, 63);
      LAS float* sw = (LAS float*)(lds + S1_SW) + w * 128;
      sw[2 * lane] = __expf(tot - ac0) * dt0; sw[2 * lane + 1] = __expf(tot - ac1) * dt1;
      if (lane == 63) dec[c * 32 + hh] = __expf(tot); }
    __syncthreads();
    if (tid < 256) { const int lr = tid & 15, cg = tid >> 4; conv_tile8<true>(lds + S1_BT, P, row0, 2048 + g * 128 + cg * 8, cg, lr, conv_w, conv_b, nullptr); }
#pragma unroll 1
    for (int half = 0; half < 2; ++half) {
        if (half) __syncthreads();
        { const int lr = tid & 15, cg = tid >> 4; conv_tile8<true>(lds + S1_XW, P, row0, g * 512 + half * 256 + cg * 8, cg, lr, conv_w, conv_b, (const LAS float*)(lds + S1_SW) + (half * 4 + (cg >> 3)) * 128); }
        __syncthreads();
        const int hl = w >> 1, ph = w & 1;
        f32x4 acc[2][8];
#pragma unroll
        for (int pt = 0; pt < 2; ++pt)
#pragma unroll
            for (int nt = 0; nt < 8; ++nt) acc[pt][nt] = (f32x4){0.f, 0.f, 0.f, 0.f};
#pragma unroll
        for (int ks = 0; ks < 4; ++ks) { bf16x8 xf[2];
#pragma unroll
            for (int pt = 0; pt < 2; ++pt) xf[pt] = *(const LAS bf16x8*)(lds + S1_XW + (hl * 64 + ph * 32 + 16 * pt + fr) * 272 + (32 * ks + 8 * kg) * 2);
#pragma unroll
            for (int nt = 0; nt < 8; ++nt) { const bf16x8 bfr = *(const LAS bf16x8*)(lds + S1_BT + (16 * nt + fr) * 272 + (32 * ks + 8 * kg) * 2);
#pragma unroll
                for (int pt = 0; pt < 2; ++pt) acc[pt][nt] = MFMA16(bfr, xf[pt], acc[pt][nt]); } }
        const int hh = 8 * g + half * 4 + hl;
#pragma unroll
        for (int pt = 0; pt < 2; ++pt) { bf16* sp = states + ((size_t)(c * 32 + hh) * 64 + ph * 32 + 16 * pt + fr) * 128 + 4 * kg;
#pragma unroll
            for (int nt = 0; nt < 8; ++nt) { u32x2 ow; ow.x = cvtpk(acc[pt][nt][0], acc[pt][nt][1]); ow.y = cvtpk(acc[pt][nt][2], acc[pt][nt][3]); *(u32x2*)(sp + 16 * nt) = ow; } }
    }
    __syncthreads();
}
__device__ __forceinline__ void scan_phase(bf16* states, const float* dec, int gtid, int nthr) {
    for (int e = gtid; e < 131072; e += nthr) { const int head = e >> 12; unsigned* p = (unsigned*)states + (size_t)head * 4096 + (e & 4095);
        float h0 = 0.f, h1 = 0.f;
#pragma unroll 32
        for (int c = 0; c < 64; ++c) { const float d = dec[c * 32 + head]; const unsigned v = p[(size_t)c * 131072]; p[(size_t)c * 131072] = cvtpk(h0, h1); h0 = d * h0 + bflo(v); h1 = d * h1 + bfhi(v); } }
}
constexpr int S3_CS = 0, S3_R = 34816, S3_AC = 104448, S3_DT = 108544;
__device__ __forceinline__ void s3_unit(LAS unsigned char* lds, bf16* P, const float* dtbuf, const bf16* states, int c, int g,
                                        const float* conv_w, const float* conv_b, const float* dt_bias, const float* a_log, const float* d_skip, const float* norm_w, int tid_in) {
    int tid = tid_in; asm volatile("" : "+v"(tid));
    const int lane = tid & 63, w = __builtin_amdgcn_readfirstlane(tid >> 6), fr = lane & 15, kg = lane >> 4;
    const int row0 = c * 128;
    { const int hh = 8 * g + w; const float Aneg = -__expf(a_log[hh]); float dt0, dt1, ac0, ac1;
      chunk_decay(dtbuf, row0, hh, dt_bias[hh], Aneg, lane, dt0, dt1, ac0, ac1);
      LAS float* ac = (LAS float*)(lds + S3_AC) + w * 128; LAS float* dv = (LAS float*)(lds + S3_DT) + w * 128;
      ac[2 * lane] = ac0; ac[2 * lane + 1] = ac1; dv[2 * lane] = dt0; dv[2 * lane + 1] = dt1; }
    { const int which = tid >> 8, t2 = tid & 255, cg = t2 & 15, lr = t2 >> 4;
      conv_tile8<false>(lds + (which ? S3_R : S3_CS), P, row0, (which ? 2048 : 2560) + g * 128 + cg * 8, cg, lr, conv_w, conv_b, nullptr); }
    __syncthreads();
    f32x4 cb[8];
    { bf16x8 cf[4];
#pragma unroll
    for (int ks = 0; ks < 4; ++ks) cf[ks] = *(const LAS bf16x8*)(lds + S3_CS + (16 * w + fr) * 272 + (32 * ks + 8 * kg) * 2);
#pragma unroll
    for (int ts = 0; ts < 8; ++ts) { f32x4 acc = {0.f, 0.f, 0.f, 0.f};
        if (ts <= w) {
#pragma unroll
            for (int ks = 0; ks < 4; ++ks) { const bf16x8 bfr = *(const LAS bf16x8*)(lds + S3_R + (16 * ts + fr) * 272 + (32 * ks + 8 * kg) * 2); acc = MFMA16(bfr, cf[ks], acc); } }
        cb[ts] = acc; } }
    asm volatile("" ::: "memory");
    float ssq = 0.f;
    const int lme = 16 * w + fr;
#pragma unroll 1
    for (int hidx = 0; hidx < 8; ++hidx) {
        if ((hidx & 3) == 0) {
            __syncthreads();
            { const int half = hidx >> 2, lr = tid & 15, cg = tid >> 4; conv_tile8<true>(lds + S3_R, P, row0, g * 512 + half * 256 + cg * 8, cg, lr, conv_w, conv_b, nullptr); }
            __syncthreads();
        }
        const int hl = hidx & 3, hh = 8 * g + hidx;
        const LAS float* ac = (const LAS float*)(lds + S3_AC) + hidx * 128; const LAS float* dv = (const LAS float*)(lds + S3_DT) + hidx * 128;
        const float acl = ac[lme];
        f32x4 accD[4], accO[4];
#pragma unroll
        for (int pt = 0; pt < 4; ++pt) { accD[pt] = (f32x4){0.f, 0.f, 0.f, 0.f}; accO[pt] = (f32x4){0.f, 0.f, 0.f, 0.f}; }
#pragma unroll
        for (int ks = 0; ks < 4; ++ks) {
            if (2 * ks <= w) { float mv[8];
#pragma unroll
                for (int tsub = 0; tsub < 2; ++tsub) { const int ts = 2 * ks + tsub; const f32x4 as = *(const LAS f32x4*)(ac + 16 * ts + 4 * kg), ds = *(const LAS f32x4*)(dv + 16 * ts + 4 * kg);
#pragma unroll
                    for (int j = 0; j < 4; ++j) { const int sidx = 16 * ts + 4 * kg + j; mv[4 * tsub + j] = (sidx <= lme) ? cb[ts][j] * __expf(acl - as[j]) * ds[j] : 0.f; } }
                u32x4 mw; mw.x = cvtpk(mv[0], mv[1]); mw.y = cvtpk(mv[2], mv[3]); mw.z = cvtpk(mv[4], mv[5]); mw.w = cvtpk(mv[6], mv[7]);
                const bf16x8 mf = __builtin_bit_cast(bf16x8, mw);
#pragma unroll
                for (int pt = 0; pt < 4; ++pt) { const int chan = hl * 64 + 16 * pt + fr;
                    const u32x2 lo = *(const LAS u32x2*)(lds + S3_R + chan * 272 + (32 * ks + 4 * kg) * 2), hi = *(const LAS u32x2*)(lds + S3_R + chan * 272 + (32 * ks + 16 + 4 * kg) * 2);
                    const u32x4 xw = {lo.x, lo.y, hi.x, hi.y}; accD[pt] = MFMA16(__builtin_bit_cast(bf16x8, xw), mf, accD[pt]); } } }
        { bf16x8 cf2[4];
#pragma unroll
          for (int ks = 0; ks < 4; ++ks) cf2[ks] = *(const LAS bf16x8*)(lds + S3_CS + (16 * w + fr) * 272 + (32 * ks + 8 * kg) * 2);
#pragma unroll
        for (int pt = 0; pt < 4; ++pt) { const bf16* pp = states + ((size_t)(c * 32 + hh) * 64 + 16 * pt + fr) * 128 + 8 * kg;
#pragma unroll
            for (int ks = 0; ks < 4; ++ks) { const bf16x8 pf = *(const bf16x8*)(pp + 32 * ks); accO[pt] = MFMA16(pf, cf2[ks], accO[pt]); }
            asm volatile("" ::: "memory"); } }
        const float ea = __expf(acl), Dh = d_skip[hh];
#pragma unroll
        for (int pt = 0; pt < 4; ++pt) { const int p0 = 16 * pt + 4 * kg;
            bf16* zp = P + (size_t)(row0 + lme) * LDP + PC_Z + hh * 64 + p0; const u32x2 zv = *(const u32x2*)zp;
            const float zs[4] = {bflo(zv.x), bfhi(zv.x), bflo(zv.y), bfhi(zv.y)}; float uu[4];
#pragma unroll
            for (int j = 0; j < 4; ++j) { const float xs = __uint_as_float((unsigned)(*(const LAS unsigned short*)(lds + S3_R + (hl * 64 + p0 + j) * 272 + lme * 2)) << 16);
                uu[j] = (accD[pt][j] + ea * accO[pt][j] + Dh * xs) * siluf_(zs[j]); }
            u32x2 uw; uw.x = cvtpk(uu[0], uu[1]); uw.y = cvtpk(uu[2], uu[3]);
            ssq += bflo(uw.x) * bflo(uw.x) + bfhi(uw.x) * bfhi(uw.x) + bflo(uw.y) * bflo(uw.y) + bfhi(uw.y) * bfhi(uw.y);
            *(u32x2*)zp = uw; }
    }
    ssq += __shfl_xor(ssq, 16); ssq += __shfl_xor(ssq, 32);
    const float rs = 1.0f / sqrtf(ssq * (1.0f / 512.0f) + RMS_EPS);
#pragma unroll 1
    for (int hidx = 0; hidx < 8; ++hidx)
#pragma unroll
        for (int pt = 0; pt < 4; ++pt) { const int col = (8 * g + hidx) * 64 + 16 * pt + 4 * kg; const f32x4 nw = *(const f32x4*)(norm_w + col);
            bf16* up = P + (size_t)(row0 + lme) * LDP + PC_Z + col; const u32x2 uv = *(const u32x2*)up;
            u32x2 ow; ow.x = cvtpk(bflo(uv.x) * rs * nw[0], bfhi(uv.x) * rs * nw[1]); ow.y = cvtpk(bflo(uv.y) * rs * nw[2], bfhi(uv.y) * rs * nw[3]); *(u32x2*)up = ow; }
    __syncthreads();
}
typedef __attribute__((address_space(4))) const char* kptr_t;
typedef void* vp_t; typedef __attribute__((address_space(4))) const vp_t* kpp_t;
#define KARG_PTR(off) ({ kptr_t kp_ = (kptr_t)__builtin_amdgcn_kernarg_segment_ptr(); asm volatile("" : "+s"(kp_)); *(kpp_t)(kp_ + (off)); })
#define IN(i) ((const float*)KARG_PTR(8 * (i)))
#define OUTP ((float*)KARG_PTR(192))
#define WSP ((unsigned char*)KARG_PTR(200))
#define Wgu ((bf16*)(WSP + WS_WGU))
#define Wd ((bf16*)(WSP + WS_WD))
#define Win ((bf16*)(WSP + WS_WIN))
#define Wcat ((bf16*)(WSP + WS_WCAT))
#define Wout ((bf16*)(WSP + WS_WOUT))
#define x1f ((float*)(WSP + WS_X1F))
#define big ((bf16*)(WSP + WS_BIG))
#define dtbuf ((float*)(WSP + WS_DT))
#define dec ((float*)(WSP + WS_DEC))
#define xb ((bf16*)((unsigned char*)OUTP + DO_XB))
#define states ((bf16*)((unsigned char*)OUTP + DO_ST))
struct Args { const float* in[24]; float* out; unsigned char* ws; };
__global__ void __launch_bounds__(NTHR, 2) mega_fwd(Args a) {
    extern __shared__ __attribute__((aligned(16))) unsigned char lds_raw[];
    LAS unsigned char* lds = (LAS unsigned char*)lds_raw;
    cg::grid_group grid = cg::this_grid();
    const int G = gridDim.x, bid = blockIdx.x, NGW = G * NWAVES, nthr = G * NTHR;
#define TID_FRESH() ({ int t_ = threadIdx.x; asm volatile("" : "+v"(t_)); t_; })
#define PHASE_IDS const int tid = TID_FRESH(); const int lane = tid & 63, wave = __builtin_amdgcn_readfirstlane(tid >> 6), gw = bid * NWAVES + wave, gtid = bid * NTHR + tid; (void)lane; (void)gw; (void)gtid; LAS float* scr = (LAS float*)(lds + wave * 16384); (void)scr;
    volatile LAS unsigned* MISC = (volatile LAS unsigned*)(lds + LDS_BYTES - 64);
    if (threadIdx.x < 16) MISC[threadIdx.x] = 0u;
    __syncthreads();
    (void)xcd_barrier_post((unsigned*)(WSP + WS_CTL), MISC + 8);
#define GRID_BAR() do { XcdBarrier b_; b_.bar = (unsigned*)(WSP + WS_CTL); b_.x = xb_xcc_id(); b_.st = (volatile LAS unsigned*)(lds + LDS_BYTES - 64) + 8; xcd_barrier(b_); } while (0)

    { PHASE_IDS
    ffn_weight_items(IN(1), IN(2), IN(3), Wgu, Wd, scr, gw, NGW, lane);
    for (int it = gw; it < 16 * 273; it += NGW) { const int kb = it / 273, nb = it % 273, n0 = nb * 32; tr_item(IN(6), 8736, kb * 64, n0, Win, 1024, map_in(n0), kb * 64, scr, lane); }
    for (int i = gtid; i < 224 * 1024 / 8; i += nthr) *((u32x4*)(Win + (size_t)8736 * 1024) + i) = (u32x4){0u, 0u, 0u, 0u};
    { const float* xin = IN(0); bf16* xbo = xb;
    for (int i = gtid; i < M * 1024 / 8; i += nthr) { const f32x4 v0 = *((const f32x4*)xin + 2 * (size_t)i), v1 = *((const f32x4*)xin + 2 * (size_t)i + 1);
        u32x4 o; o.x = cvtpk(v0.x, v0.y); o.y = cvtpk(v0.z, v0.w); o.z = cvtpk(v1.x, v1.y); o.w = cvtpk(v1.z, v1.w); *((u32x4*)xbo + i) = o; } } }
    grid.sync();
#ifndef SKIP_GEMM1
    { pg8::Gemm g{xb, Wgu, M, 2 * DFF, 1024, 1024}; pg8::StaticOrder S; S.init(M, 2 * DFF, G, bid); pg8::EpiSwiGLU E{0, big, DFF};
      pg8::gemm_phase<pg8::EpiSwiGLU, pg8::StaticOrder, true, true>(lds, g, S, E); }
#endif
    GRID_BAR();
#ifndef SKIP_GEMM2
    { pg8::Gemm g{big, Wd, M, 1024, DFF, DFF}; pg8::StaticOrder S; S.init(M, 1024, G, bid); pg8::EpiResid E{0, IN(0), x1f, 1024, ALPHA, 0.5f};
      pg8::gemm_phase<pg8::EpiResid, pg8::StaticOrder, true, true>(lds, g, S, E); }
#endif
    GRID_BAR();
    { PHASE_IDS ln_rows(x1f, x1f, xb, IN(4), IN(5), M, gw, NGW, lane); }
    GRID_BAR();
#pragma unroll 1
    for (int b = 0; b < 2; ++b) {
#ifndef SKIP_GEMM3
        { pg8::Gemm g{xb + (size_t)b * MB * 1024, Win, MB, NPROJ, 1024, 1024}; pg8::StaticOrder S; S.init(MB, NPROJ, G, bid); pg8::EpiInProj E{0, big, LDP, dtbuf};
          pg8::gemm_phase<pg8::EpiInProj, pg8::StaticOrder, true, true>(lds, g, S, E); }
#endif
        if (bid >= 96) { PHASE_IDS const int gw2 = (bid - 96) * NWAVES + wave, NGW2 = (G - 96) * NWAVES;
            if (b == 0) {
    for (int it = gw2; it < 512 + 1024 + 512; it += NGW2) { int r = it;
                if (r < 512) { tr_item(IN(14), 1024, (r >> 5) * 64, (r & 31) * 32, Wcat, 1024, (r & 31) * 32, (r >> 5) * 64, scr, lane); continue; } r -= 512;
                if (r < 1024) { tr_item(IN(15), 1024, (r >> 5) * 64, (r & 31) * 32, Wcat + (size_t)1024 * 1024, 2048, (r & 31) * 32, (r >> 5) * 64, scr, lane); continue; } r -= 1024;
                tr_item(IN(16), 1024, (r >> 5) * 64, (r & 31) * 32, Wout, 1024, (r & 31) * 32, (r >> 5) * 64, scr, lane); }
            } else ffn_weight_items(IN(19), IN(20), IN(21), Wgu, Wd, scr, gw2, NGW2, lane); }
        GRID_BAR();
#ifndef SKIP_S1
        for (int u = bid; u < 256; u += G) s1_unit(lds, big, dtbuf, dec, states, u >> 2, u & 3, IN(7), IN(8), IN(9), IN(10), threadIdx.x);
#endif
#ifndef SKIP_ATTN
        for (int u = bid; u < 1024; u += G) attn_unit(lds, big, u >> 4, u & 15, IN(13)[u & 15], threadIdx.x);
#endif
        GRID_BAR();
        { PHASE_IDS scan_phase(states, dec, gtid, nthr); }
        GRID_BAR();
#ifndef SKIP_S3
        for (int u = bid; u < 256; u += G) s3_unit(lds, big, dtbuf, states, u >> 2, u & 3, IN(7), IN(8), IN(9), IN(10), IN(11), IN(12), threadIdx.x);
#endif
        GRID_BAR();
#ifndef SKIP_G4
        { pg8::Gemm g{big + PC_Q, Wcat, MB, 1024, 1024, LDP}; pg8::StaticOrder S; S.init(MB, 1024, G, bid); pg8::EpiGate<0> E{0, big + PC_GA, LDP, PC_GS - PC_GA, nullptr, 0};
          pg8::gemm_phase<pg8::EpiGate<0>, pg8::StaticOrder, true, true>(lds, g, S, E); }
        { pg8::Gemm g{big + PC_Z, Wcat + (size_t)1024 * 1024, MB, 1024, 2048, LDP}; pg8::StaticOrder S; S.init(MB, 1024, G, bid); pg8::EpiGate<1> E{0, big + PC_GA, LDP, PC_GS - PC_GA, xb + (size_t)b * MB * 1024, 1024};
          pg8::gemm_phase<pg8::EpiGate<1>, pg8::StaticOrder, true, true>(lds, g, S, E); }
#endif
        GRID_BAR();
    }
    { pg8::Gemm g{xb, Wout, M, 1024, 1024, 1024}; pg8::StaticOrder S; S.init(M, 1024, G, bid); pg8::EpiResid E{0, x1f, x1f, 1024, ALPHA, 1.0f};
      pg8::gemm_phase<pg8::EpiResid, pg8::StaticOrder, true, true>(lds, g, S, E); }
    GRID_BAR();
    { PHASE_IDS ln_rows(x1f, x1f, xb, IN(17), IN(18), M, gw, NGW, lane); }
    GRID_BAR();
#ifndef SKIP_GEMM5
    { pg8::Gemm g{xb, Wgu, M, 2 * DFF, 1024, 1024}; pg8::StaticOrder S; S.init(M, 2 * DFF, G, bid); pg8::EpiSwiGLU E{0, big, DFF};
      pg8::gemm_phase<pg8::EpiSwiGLU, pg8::StaticOrder, true, true>(lds, g, S, E); }
#endif
    GRID_BAR();
#ifndef SKIP_GEMM6
    { pg8::Gemm g{big, Wd, M, 1024, DFF, DFF}; pg8::StaticOrder S; S.init(M, 1024, G, bid); pg8::EpiResid E{0, x1f, OUTP, 1024, ALPHA, 0.5f};
      pg8::gemm_phase<pg8::EpiResid, pg8::StaticOrder, true, true>(lds, g, S, E); }
#endif
    GRID_BAR();
    { PHASE_IDS ln_rows(OUTP, OUTP, nullptr, IN(22), IN(23), M, gw, NGW, lane); }
}

#undef Wgu
#undef Wd
#undef Win
#undef Wcat
#undef Wout
#undef x1f
#undef big
#undef dtbuf
#undef dec
#undef xb
#undef states
extern "C" void kernel_launch(void* const* d_in, const int* in_sizes, int n_in, void* d_out, int out_size, void* d_ws, size_t ws_size, hipStream_t stream) {
    static int grid = 0;
    if (grid == 0) {
        if (n_in != 24 || out_size != M * 1024 || ws_size < WS_END) { fprintf(stderr, "kernel_launch: unexpected shapes (n_in %d out %d ws %zu)\n", n_in, out_size, ws_size); grid = -1; return; }
        int dev = 0, cus = 0, per_cu = 0;
        (void)hipGetDevice(&dev); (void)hipDeviceGetAttribute(&cus, hipDeviceAttributeMultiprocessorCount, dev);
        (void)hipFuncSetAttribute((const void*)mega_fwd, hipFuncAttributeMaxDynamicSharedMemorySize, LDS_BYTES);
        (void)hipOccupancyMaxActiveBlocksPerMultiprocessor(&per_cu, (const void*)mega_fwd, NTHR, LDS_BYTES);
        if (per_cu < 1) per_cu = 1;
        grid = cus * per_cu; if (grid > 256) grid = 256;
        (void)hipGetLastError();
    }
    if (grid < 0) return;
    if (hipMemsetAsync((char*)d_ws + WS_CTL, 0, 65536, stream) != hipSuccess) { fprintf(stderr, "memset failed\n"); return; }
    Args a{};
    for (int i = 0; i < 24; ++i) a.in[i] = (const float*)d_in[i];
    a.out = (float*)d_out; a.ws = (unsigned char*)d_ws;
    void* args[] = {&a};
    hipError_t e = hipLaunchCooperativeKernel((const void*)mega_fwd, dim3(grid), dim3(NTHR), args, LDS_BYTES, stream);
    if (e != hipSuccess) fprintf(stderr, "cooperative launch failed: %s (grid %d)\n", hipGetErrorString(e), grid);
}
```

```cpp
#include <hip/hip_runtime.h>
#include <hip/hip_cooperative_groups.h>
#include <cstdio>
#include <cstdint>
namespace cg = cooperative_groups;
namespace pg8 {
#define PG8_LAS __attribute__((address_space(3)))
typedef unsigned short bf16_t;
typedef short bf16x8 __attribute__((ext_vector_type(8)));
typedef float f32x4 __attribute__((ext_vector_type(4)));
typedef unsigned u32x4 __attribute__((ext_vector_type(4)));
constexpr int BM = 256, BK = 64, HALF = 128, HTB = HALF * BK * 2  , STAGE_BYTES = 8 * HTB, NXCD = 8, WGM = 8;

__host__ __device__ __forceinline__ int lds_byte(int r, int c) { const int st = (r >> 4) * 2 + (c >> 5), rr = r & 15, cc = c & 31, ob = rr * 64 + cc * 2; return st * 1024 + (ob ^ (((ob >> 9) & 1) << 5)); }
__host__ __device__ __forceinline__ void stage_rc(int b, int& R, int& C) { const int st = b / 1024, sb = b % 1024, swz = sb ^ (((sb >> 9) & 1) << 5); R = (st >> 1) * 16 + swz / 64; C = (st & 1) * 32 + (swz % 64) / 2; }
__host__ __device__ __forceinline__ int perm32(int rho) { const int n = rho >> 4, i = rho & 15; return 8 * (i >> 2) + 4 * n + (i & 3); }

struct Unit { int pm, pn; };
struct Gemm { const bf16_t* A; const bf16_t* Bt; int M, N, K, lda; };

struct StaticOrder {
    int nM, nN, nwg, G, c;
    __host__ __device__ void init(int M, int N, int G_, int c_) { nM = M / BM; nN = N / BM; nwg = nM * nN; G = G_; c = c_; }
    __host__ __device__ bool next(int i, Unit& u) const {
        const long L = (long)i * G + c; if (L >= nwg) return false;
        int wgid = (int)L; { const int q = nwg / NXCD, r = nwg % NXCD, xcd = wgid % NXCD, off = wgid / NXCD; wgid = (xcd < r ? xcd * (q + 1) : r * (q + 1) + (xcd - r) * q) + off; }
        const int nig = WGM * nN, gid = wgid / nig, fm = gid * WGM, gsz = (nM - fm) < WGM ? (nM - fm) : WGM;
        u.pm = fm + ((wgid % nig) % gsz); u.pn = (wgid % nig) / gsz; return true;
    }
    __device__ __forceinline__ void a_ready(const Unit&) const {}
    __device__ __forceinline__ void done(const Unit&) const {}
};

typedef float f32x2_t __attribute__((ext_vector_type(2))); typedef __bf16 bf16x2_t __attribute__((ext_vector_type(2)));
__device__ __forceinline__ unsigned cvtpk(float lo, float hi) { f32x2_t v = {lo, hi}; bf16x2_t b = __builtin_convertvector(v, bf16x2_t); return __builtin_bit_cast(unsigned, b); }
__device__ __forceinline__ float bflo(unsigned w) { return __uint_as_float(w << 16); }
__device__ __forceinline__ float bfhi(unsigned w) { return __uint_as_float(w & 0xffff0000u); }
__device__ __forceinline__ float sigmoidf_(float x) { return __builtin_amdgcn_rcpf(1.0f + __builtin_amdgcn_exp2f(-1.4426950408889634f * x)); }
__device__ __forceinline__ float siluf_(float x) { return x * sigmoidf_(x); }

struct EpiSwiGLU {
    static constexpr bool PERM = true, AFTER_DRAIN = false, HAS_MID = false; int mid_t;
    bf16_t* O; int ldc;
    __device__ __forceinline__ void mid(f32x4 (&)[2][2][4][2], const Unit&, int, int, int, int) const {}
    __device__ __forceinline__ void operator()(const f32x4 (&acc)[2][2][4][2], const Unit& u, int wr, int wc, int fr, int fq) const {
        const int row0 = u.pm * BM + wr * 64 + fr, col0 = u.pn * HALF + wc * 32 + 8 * fq;
#pragma unroll
        for (int ai = 0; ai < 2; ++ai)
#pragma unroll
            for (int m = 0; m < 4; ++m) { bf16_t* rowp = O + (size_t)(row0 + ai * HALF + m * 16) * ldc + col0;
                const f32x4 g0 = acc[ai][0][m][0], g1 = acc[ai][0][m][1], u0 = acc[ai][1][m][0], u1 = acc[ai][1][m][1];
                u32x4 w; w.x = cvtpk(siluf_(g0[0]) * u0[0], siluf_(g0[1]) * u0[1]); w.y = cvtpk(siluf_(g0[2]) * u0[2], siluf_(g0[3]) * u0[3]);
                w.z = cvtpk(siluf_(g1[0]) * u1[0], siluf_(g1[1]) * u1[1]); w.w = cvtpk(siluf_(g1[2]) * u1[2], siluf_(g1[3]) * u1[3]);
                *(u32x4*)rowp = w; }
    }
};
struct EpiResid {
    static constexpr bool PERM = false, AFTER_DRAIN = false, HAS_MID = false; int mid_t;
    const float* res; float* out; int ldc; float alpha, s;
    __device__ __forceinline__ void mid(f32x4 (&)[2][2][4][2], const Unit&, int, int, int, int) const {}
    __device__ __forceinline__ void operator()(const f32x4 (&acc)[2][2][4][2], const Unit& u, int wr, int wc, int fr, int fq) const {
        const int row0 = u.pm * BM + wr * 64 + fr, col0 = u.pn * BM + wc * 32 + 4 * fq;
#pragma unroll
        for (int ai = 0; ai < 2; ++ai)
#pragma unroll
            for (int m = 0; m < 4; ++m) { const size_t off = (size_t)(row0 + ai * HALF + m * 16) * ldc + col0;
#pragma unroll
                for (int bj = 0; bj < 2; ++bj)
#pragma unroll
                    for (int n = 0; n < 2; ++n) { const f32x4 r = *(const f32x4*)(res + off + bj * HALF + n * 16); *(f32x4*)(out + off + bj * HALF + n * 16) = r * alpha + acc[ai][bj][m][n] * s; } }
    }
};
struct EpiInProj {
    static constexpr bool PERM = true, AFTER_DRAIN = false, HAS_MID = false; int mid_t;
    bf16_t* O; int ldc; float* dt;
    __device__ __forceinline__ void mid(f32x4 (&)[2][2][4][2], const Unit&, int, int, int, int) const {}
    __device__ __forceinline__ void operator()(const f32x4 (&acc)[2][2][4][2], const Unit& u, int wr, int wc, int fr, int fq) const {
        const int row0 = u.pm * BM + wr * 64 + fr;
        if (u.pn == 34) {
            if (wc == 0) {
#pragma unroll
                for (int ai = 0; ai < 2; ++ai)
#pragma unroll
                    for (int m = 0; m < 4; ++m) { float* p = dt + (size_t)(row0 + ai * HALF + m * 16) * 32 + 8 * fq; *(f32x4*)p = acc[ai][0][m][0]; *(f32x4*)(p + 4) = acc[ai][0][m][1]; }
            }
            return;
        }
        const bool gate = u.pn >= 26; const int col0 = u.pn * BM + wc * 32 + 8 * fq;
#pragma unroll
        for (int ai = 0; ai < 2; ++ai)
#pragma unroll
            for (int m = 0; m < 4; ++m) { bf16_t* rowp = O + (size_t)(row0 + ai * HALF + m * 16) * ldc + col0;
#pragma unroll
                for (int bj = 0; bj < 2; ++bj) { f32x4 v0 = acc[ai][bj][m][0], v1 = acc[ai][bj][m][1];
                    if (gate) {
#pragma unroll
                        for (int i = 0; i < 4; ++i) { v0[i] = sigmoidf_(v0[i]); v1[i] = sigmoidf_(v1[i]); } }
                    u32x4 w; w.x = cvtpk(v0[0], v0[1]); w.y = cvtpk(v0[2], v0[3]); w.z = cvtpk(v1[0], v1[1]); w.w = cvtpk(v1[2], v1[3]);
                    *(u32x4*)(rowp + bj * HALF) = w; } }
    }
};
template <int MODE> struct EpiGate {
    static constexpr bool PERM = true, AFTER_DRAIN = false, HAS_MID = false; int mid_t;
    bf16_t* G; int ldc; int gsoff; bf16_t* O2; int ldo;
    __device__ __forceinline__ void mid(f32x4 (&)[2][2][4][2], const Unit&, int, int, int, int) const {}
    __device__ __forceinline__ void operator()(const f32x4 (&acc)[2][2][4][2], const Unit& u, int wr, int wc, int fr, int fq) const {
        const int row0 = u.pm * BM + wr * 64 + fr, col0 = u.pn * BM + wc * 32 + 8 * fq;
#pragma unroll
        for (int ai = 0; ai < 2; ++ai)
#pragma unroll
            for (int m = 0; m < 4; ++m) { bf16_t* rowp = G + (size_t)(row0 + ai * HALF + m * 16) * ldc + col0; bf16_t* orow = (MODE == 0) ? rowp : O2 + (size_t)(row0 + ai * HALF + m * 16) * ldo + col0;
#pragma unroll
                for (int bj = 0; bj < 2; ++bj) { const u32x4 t = *(const u32x4*)(rowp + bj * HALF); const f32x4 v0 = acc[ai][bj][m][0], v1 = acc[ai][bj][m][1]; u32x4 w;
                    if (MODE == 0) { w.x = cvtpk(v0[0] * bflo(t.x), v0[1] * bfhi(t.x)); w.y = cvtpk(v0[2] * bflo(t.y), v0[3] * bfhi(t.y));
                        w.z = cvtpk(v1[0] * bflo(t.z), v1[1] * bfhi(t.z)); w.w = cvtpk(v1[2] * bflo(t.w), v1[3] * bfhi(t.w)); }
                    else { const u32x4 s = *(const u32x4*)(rowp + bj * HALF + gsoff);
                        w.x = cvtpk(bflo(t.x) + v0[0] * bflo(s.x), bfhi(t.x) + v0[1] * bfhi(s.x)); w.y = cvtpk(bflo(t.y) + v0[2] * bflo(s.y), bfhi(t.y) + v0[3] * bfhi(s.y));
                        w.z = cvtpk(bflo(t.z) + v1[0] * bflo(s.z), bfhi(t.z) + v1[1] * bfhi(s.z)); w.w = cvtpk(bflo(t.w) + v1[2] * bflo(s.w), bfhi(t.w) + v1[3] * bfhi(s.w)); }
                    *(u32x4*)(orow + bj * HALF) = w; } }
    }
};
template <class Epi, class Sched, bool ALIGN_EPI = false, bool SP2 = false>
__device__ __forceinline__ void gemm_phase(PG8_LAS unsigned char* lds, const Gemm g, const Sched& S, const Epi& E) {
    int tid_ = threadIdx.x; asm volatile("" : "+v"(tid_)); const int tid = tid_, wid = __builtin_amdgcn_readfirstlane(tid >> 6), lane = tid & 63, wr = wid >> 2, wc = wid & 3, fr = lane & 15, fq = lane >> 4;
    const int K = g.K, nt = K / BK;
    unsigned voffA[2], voffB[2];
#pragma unroll
    for (int i = 0; i < 2; ++i) { int R, C; stage_rc(tid * 16 + i * 8192, R, C); const int Rb = Epi::PERM ? ((R & ~31) + perm32(R & 31)) : R;
        voffA[i] = (unsigned)(R * g.lda + C) * 2u; voffB[i] = (unsigned)(Rb * K + C) * 2u; }
    const size_t kstep = (size_t)(BK * 2);
    const size_t hstepB = (size_t)HALF * K * 2, hstepA = (size_t)HALF * g.lda * 2;
    const size_t tstepA = 2 * hstepA, tstepB = 2 * hstepB;
    const unsigned ldsw = (unsigned)wid * 1024u;
    const int aoff = lds_byte(wr * 64 + fr, fq * 8), boff = lds_byte(wc * 32 + fr, fq * 8);
#define PG8_SA(b, h) (((b) * 2 + (h)) * HTB)
#define PG8_SB(b, h) ((4 + (b) * 2 + (h)) * HTB)
#define PG8_STAGE(bufoff, gbase, voff) do { _Pragma("unroll") for (int _i = 0; _i < 2; ++_i) \
        __builtin_amdgcn_global_load_lds((const unsigned*)((const char*)(gbase) + (voff)[_i]), (PG8_LAS unsigned*)(lds + (bufoff) + ldsw + _i * 8192), 16, 0, 0); } while (0)
#define PG8_LDA(dst, b, h) do { _Pragma("unroll") for (int m = 0; m < 4; ++m) _Pragma("unroll") for (int k = 0; k < 2; ++k) dst[m][k] = *(const PG8_LAS bf16x8*)(lds + PG8_SA(b, h) + aoff + m * 2048 + k * 1024); } while (0)
#define PG8_LDB(dst, b, h) do { _Pragma("unroll") for (int n = 0; n < 2; ++n) _Pragma("unroll") for (int k = 0; k < 2; ++k) dst[n][k] = *(const PG8_LAS bf16x8*)(lds + PG8_SB(b, h) + boff + n * 2048 + k * 1024); } while (0)
#define PG8_MMA(ai, bj, At, Bt) do { __builtin_amdgcn_s_setprio(1); _Pragma("unroll") for (int m = 0; m < 4; ++m) _Pragma("unroll") for (int n = 0; n < 2; ++n) _Pragma("unroll") for (int k = 0; k < 2; ++k) \
        acc[ai][bj][m][n] = __builtin_amdgcn_mfma_f32_16x16x32_bf16(Bt[n][k], At[m][k], acc[ai][bj][m][n], 0, 0, 0); __builtin_amdgcn_s_setprio(0); } while (0)
#define PG8_WAIT_V(n) asm volatile("s_waitcnt vmcnt(" #n ")" ::: "memory")
#define PG8_WAIT_L(n) asm volatile("s_waitcnt lgkmcnt(" #n ")" ::: "memory")
#define PG8_BAR __builtin_amdgcn_s_barrier()
#define PG8_SCHED __builtin_amdgcn_sched_barrier(0)
    Unit cur, nxt; int ui = 0;
    if (!S.next(0, cur)) return;
    f32x4 acc[2][2][4][2];
#pragma unroll
    for (int a = 0; a < 2; ++a)
#pragma unroll
        for (int b = 0; b < 2; ++b)
#pragma unroll
            for (int m = 0; m < 4; ++m)
#pragma unroll
                for (int n = 0; n < 2; ++n) acc[a][b][m][n] = (f32x4){0.f, 0.f, 0.f, 0.f};
    bf16x8 At[4][2], B0[2][2], B1[2][2];
    const char* cA = (const char*)g.A + (size_t)cur.pm * tstepA; const char* cB = (const char*)g.Bt + (size_t)cur.pn * tstepB;
    S.a_ready(cur);
    if constexpr (SP2) {
        PG8_STAGE(PG8_SB(0, 0), cB, voffB); PG8_STAGE(PG8_SB(0, 1), cB + hstepB, voffB); PG8_STAGE(PG8_SA(0, 0), cA, voffA); PG8_STAGE(PG8_SA(0, 1), cA + hstepA, voffA);
        if (wr == 1) PG8_BAR;
        PG8_WAIT_V(2); PG8_BAR;
        PG8_STAGE(PG8_SB(1, 0), cB + kstep, voffB); PG8_STAGE(PG8_SA(1, 0), cA + kstep, voffA); PG8_STAGE(PG8_SB(1, 1), cB + hstepB + kstep, voffB);
        PG8_WAIT_V(6); PG8_BAR;
    } else {
        PG8_STAGE(PG8_SB(0, 0), cB, voffB); PG8_STAGE(PG8_SA(0, 0), cA, voffA); PG8_STAGE(PG8_SB(0, 1), cB + hstepB, voffB); PG8_STAGE(PG8_SA(0, 1), cA + hstepA, voffA);
        if (wr == 1) PG8_BAR;
        PG8_WAIT_V(4); PG8_BAR;
        PG8_STAGE(PG8_SB(1, 0), cB + kstep, voffB); PG8_STAGE(PG8_SA(1, 0), cA + kstep, voffA); PG8_STAGE(PG8_SB(1, 1), cB + hstepB + kstep, voffB);
        PG8_WAIT_V(6); PG8_BAR;
    }
    for (;;) {
        const bool has_next = S.next(ui + 1, nxt);
        const char* nA = has_next ? (const char*)g.A + (size_t)nxt.pm * tstepA : cA; const char* nB = has_next ? (const char*)g.Bt + (size_t)nxt.pn * tstepB : cB;
        for (int t = 0; t < nt; t += 2) {
            if constexpr (Epi::HAS_MID) { if (t == E.mid_t) E.mid(acc, cur, wr, wc, fr, fq); }
            const bool last = (t == nt - 2);
            const char* a1 = cA + (size_t)(t + 1) * kstep;
            const char* a2 = last ? nA : cA + (size_t)(t + 2) * kstep; const char* b2 = last ? nB : cB + (size_t)(t + 2) * kstep;
            const char* a3 = a2 + kstep; const char* b3 = b2 + kstep;
            if (last && has_next) S.a_ready(nxt);
            if constexpr (SP2) {
            PG8_LDB(B0, 0, 0); PG8_LDB(B1, 0, 1); PG8_SCHED; PG8_LDA(At, 0, 0); PG8_STAGE(PG8_SA(1, 1), a1 + hstepA, voffA);
            PG8_WAIT_V(8); PG8_WAIT_L(0); PG8_BAR; PG8_MMA(0, 0, At, B0); PG8_MMA(0, 1, At, B1); PG8_BAR; PG8_SCHED;
            PG8_LDA(At, 0, 1); PG8_STAGE(PG8_SB(0, 0), b2, voffB); PG8_STAGE(PG8_SB(0, 1), b2 + hstepB, voffB); PG8_STAGE(PG8_SA(0, 0), a2, voffA);
            PG8_WAIT_V(8); PG8_WAIT_L(0); PG8_BAR; PG8_MMA(1, 0, At, B0); PG8_MMA(1, 1, At, B1); PG8_BAR; PG8_SCHED;
            PG8_LDB(B0, 1, 0); PG8_LDB(B1, 1, 1); PG8_SCHED; PG8_LDA(At, 1, 0); PG8_STAGE(PG8_SA(0, 1), a2 + hstepA, voffA);
            PG8_WAIT_V(8); PG8_WAIT_L(0); PG8_BAR; PG8_MMA(0, 0, At, B0); PG8_MMA(0, 1, At, B1); PG8_BAR; PG8_SCHED;
            PG8_LDA(At, 1, 1); PG8_STAGE(PG8_SB(1, 0), b3, voffB); PG8_STAGE(PG8_SB(1, 1), b3 + hstepB, voffB); PG8_STAGE(PG8_SA(1, 0), a3, voffA);
            PG8_WAIT_V(8); PG8_WAIT_L(0); PG8_BAR; PG8_MMA(1, 0, At, B0); PG8_MMA(1, 1, At, B1); PG8_BAR; PG8_SCHED;
            } else {
            PG8_LDB(B0, 0, 0); PG8_SCHED; PG8_LDA(At, 0, 0); PG8_STAGE(PG8_SA(1, 1), a1 + hstepA, voffA);
            PG8_WAIT_L(8); PG8_BAR; PG8_WAIT_L(0); PG8_MMA(0, 0, At, B0); PG8_BAR; PG8_SCHED;
            PG8_LDB(B1, 0, 1); PG8_STAGE(PG8_SB(0, 0), b2, voffB);
            PG8_BAR; PG8_WAIT_L(0); PG8_MMA(0, 1, At, B1); PG8_BAR;
            PG8_LDA(At, 0, 1); PG8_STAGE(PG8_SA(0, 0), a2, voffA);
            PG8_BAR; PG8_WAIT_L(0); PG8_MMA(1, 0, At, B0); PG8_BAR; PG8_SCHED;
            PG8_STAGE(PG8_SB(0, 1), b2 + hstepB, voffB);
            PG8_WAIT_V(6); PG8_BAR; PG8_MMA(1, 1, At, B1); PG8_BAR;
            PG8_LDB(B0, 1, 0); PG8_SCHED; PG8_LDA(At, 1, 0); PG8_STAGE(PG8_SA(0, 1), a2 + hstepA, voffA);
            PG8_WAIT_L(8); PG8_BAR; PG8_WAIT_L(0); PG8_MMA(0, 0, At, B0); PG8_BAR; PG8_SCHED;
            PG8_LDB(B1, 1, 1); PG8_STAGE(PG8_SB(1, 0), b3, voffB);
            PG8_BAR; PG8_WAIT_L(0); PG8_MMA(0, 1, At, B1); PG8_BAR;
            PG8_LDA(At, 1, 1); PG8_STAGE(PG8_SA(1, 0), a3, voffA);
            PG8_BAR; PG8_WAIT_L(0); PG8_MMA(1, 0, At, B0); PG8_BAR; PG8_SCHED;
            PG8_STAGE(PG8_SB(1, 1), b3 + hstepB, voffB);
            PG8_WAIT_V(6); PG8_BAR; PG8_MMA(1, 1, At, B1); PG8_BAR;
            }
        }
        if constexpr (ALIGN_EPI) { if (wr == 0) PG8_BAR; }
        if constexpr (!Epi::AFTER_DRAIN) { E(acc, cur, wr, wc, fr, fq); S.done(cur); }
        if (!has_next) break;
#pragma unroll
        for (int a = 0; a < 2; ++a)
#pragma unroll
            for (int b = 0; b < 2; ++b)
#pragma unroll
                for (int m = 0; m < 4; ++m)
#pragma unroll
                    for (int n = 0; n < 2; ++n) acc[a][b][m][n] = (f32x4){0.f, 0.f, 0.f, 0.f};
        cur = nxt; cA = nA; cB = nB; ++ui;
        if constexpr (ALIGN_EPI) { if (wr == 1) PG8_BAR; }
    }
    PG8_WAIT_V(0);
    if constexpr (!ALIGN_EPI) { if (wr == 0) PG8_BAR; }
    PG8_BAR;
    if constexpr (Epi::AFTER_DRAIN) { E.fused(acc, cur, wr, wc, fr, fq, lds, wid, lane); S.done(cur); }
#undef PG8_SA
#undef PG8_SB
#undef PG8_STAGE
#undef PG8_LDA
#undef PG8_LDB
#undef PG8_MMA
#undef PG8_WAIT_V
#undef PG8_WAIT_L
#undef PG8_BAR
#undef PG8_SCHED
}
}

#define LAS __attribute__((address_space(3)))
typedef unsigned short bf16;
typedef float f32x4 __attribute__((ext_vector_type(4)));
typedef short bf16x8 __attribute__((ext_vector_type(8)));
typedef short bf16x4 __attribute__((ext_vector_type(4)));
typedef unsigned u32x4 __attribute__((ext_vector_type(4)));
typedef unsigned u32x2 __attribute__((ext_vector_type(2)));
using pg8::cvtpk; using pg8::bflo; using pg8::bfhi; using pg8::siluf_; using pg8::sigmoidf_;
constexpr int NWAVES = 8, NTHR = 512;
constexpr int M = 16384, MB = 8192, DMODEL = 1024, DFF = 2816;
constexpr int LDP = 8704;
constexpr int PC_Q = 0, PC_Z = 1024, PC_K = 3072, PC_V = 3328, PC_XBC = 3584, PC_GA = 6656, PC_GS = 7680;
constexpr int NPROJ = 8960;
constexpr float LN_EPS = 1e-5f, RMS_EPS = 1e-5f;
constexpr float ALPHA = 1.189207115002721f;
constexpr size_t MiB = 1u << 20;
constexpr size_t WS_CTL = 0, WS_DEC = 512 * 1024, WS_DT = 1 * MiB, WS_WGU = 2 * MiB, WS_WD = 13 * MiB, WS_WIN = 19 * MiB, WS_WCAT = 37 * MiB, WS_WOUT = 43 * MiB, WS_X1F = 45 * MiB, WS_BIG = 109 * MiB, WS_END = 245 * MiB;
constexpr size_t DO_XB = 0, DO_ST = 32 * MiB;
constexpr int LDS_BYTES = 147456;

#define LDS_WAIT() asm volatile("s_waitcnt lgkmcnt(0)" ::: "memory")
#define MFMA16(a, b, c) __builtin_amdgcn_mfma_f32_16x16x32_bf16((a), (b), (c), 0, 0, 0)

__device__ __forceinline__ float wave_sum(float v) {
#pragma unroll
    for (int o = 1; o < 64; o <<= 1) v += __shfl_xor(v, o);
    return v;
}
__device__ __forceinline__ void tr_item(const float* W, int ldw, int k0, int n0, bf16* WT, int ldt, int drow, int dcol, LAS float* scr, int lane) {
#pragma unroll 8
    for (int i = 0; i < 32; ++i) { const int kk = 2 * i + (lane >> 5); scr[kk * 33 + (lane & 31)] = W[(size_t)(k0 + kk) * ldw + n0 + (lane & 31)]; }
    LDS_WAIT(); asm volatile("" ::: "memory");
    const int c = lane & 7;
#pragma unroll
    for (int j = 0; j < 4; ++j) { const int n = (lane >> 3) + 8 * j; const LAS float* s = scr + (8 * c) * 33 + n;
        u32x4 o; o.x = cvtpk(s[0 * 33], s[1 * 33]); o.y = cvtpk(s[2 * 33], s[3 * 33]); o.z = cvtpk(s[4 * 33], s[5 * 33]); o.w = cvtpk(s[6 * 33], s[7 * 33]);
        *(u32x4*)(WT + (size_t)(drow + n) * ldt + dcol + 8 * c) = o; }
    LDS_WAIT(); asm volatile("" ::: "memory");
}
__device__ __forceinline__ int map_in(int n0) {
    if (n0 < 1024) return n0;
    if (n0 < 1280) return PC_K + (n0 - 1024);
    if (n0 < 1536) return PC_V + (n0 - 1280);
    if (n0 < 3584) return PC_Z + (n0 - 1536);
    if (n0 < 6656) return n0;
    if (n0 < 6688) return 8704 + (n0 - 6656);
    if (n0 < 7712) return PC_GA + (n0 - 6688);
    return PC_GS + (n0 - 7712);
}
__device__ __forceinline__ void ffn_weight_items(const float* wg, const float* wu, const float* wd, bf16* Wgu, bf16* Wd, LAS float* scr, int gw, int NGW, int lane, int lo = 0, int hi = 2 * 16 * 88 + 44 * 32) {
    constexpr int I_G = 16 * 88, I_D = 44 * 32;
    for (int it = lo + gw; it < hi; it += NGW) {
        int r = it;
        if (r < 2 * I_G) { const bool up = r >= I_G; if (up) r -= I_G; const int kb = r / 88, nb = r % 88, n0 = nb * 32;
            tr_item(up ? wu : wg, DFF, kb * 64, n0, Wgu, 1024, (n0 >> 7) * 256 + (n0 & 127) + (up ? 128 : 0), kb * 64, scr, lane); continue; }
        r -= 2 * I_G; { const int kb = r / 32, nb = r % 32; tr_item(wd, 1024, kb * 64, nb * 32, Wd, DFF, nb * 32, kb * 64, scr, lane); }
    }
}
__device__ __forceinline__ void ln_rows(const float* src, float* dstf, bf16* dstb, const float* g, const float* b, int nrows, int gw, int NGW, int lane) {
    f32x4 gv[4], bv[4];
#pragma unroll
    for (int j = 0; j < 4; ++j) { gv[j] = *((const f32x4*)g + lane + 64 * j); bv[j] = *((const f32x4*)b + lane + 64 * j); }
    for (int m = gw; m < nrows; m += NGW) {
        const f32x4* xr = (const f32x4*)(src + (size_t)m * 1024) + lane;
        f32x4 v[4]; float s = 0.f;
#pragma unroll
        for (int j = 0; j < 4; ++j) { v[j] = xr[64 * j]; s += (v[j].x + v[j].y) + (v[j].z + v[j].w); }
        const float mean = wave_sum(s) * (1.f / 1024.f); float s2 = 0.f;
#pragma unroll
        for (int j = 0; j < 4; ++j) { v[j] = v[j] - mean; s2 += (v[j].x * v[j].x + v[j].y * v[j].y) + (v[j].z * v[j].z + v[j].w * v[j].w); }
        const float rstd = 1.f / sqrtf(wave_sum(s2) * (1.f / 1024.f) + LN_EPS);
#pragma unroll
        for (int j = 0; j < 4; ++j) { const f32x4 y = v[j] * rstd * gv[j] + bv[j];
            if (dstf) *((f32x4*)(dstf + (size_t)m * 1024) + lane + 64 * j) = y;
            if (dstb) { u32x2 w; w.x = cvtpk(y.x, y.y); w.y = cvtpk(y.z, y.w); *((u32x2*)(dstb + (size_t)m * 1024) + lane + 64 * j) = w; } }
    }
}
struct ConvW { f32x4 w[4][2]; f32x4 b[2]; };
__device__ __forceinline__ void conv_load_w(ConvW& cw, const float* conv_w, const float* conv_b, int xch) {
#pragma unroll
    for (int j = 0; j < 4; ++j) { cw.w[j][0] = *(const f32x4*)(conv_w + j * 3072 + xch); cw.w[j][1] = *(const f32x4*)(conv_w + j * 3072 + xch + 4); }
    cw.b[0] = *(const f32x4*)(conv_b + xch); cw.b[1] = *(const f32x4*)(conv_b + xch + 4);
}
__device__ __forceinline__ void conv8(const bf16* P, int row, int xch, const ConvW& cw, float (&o)[8]) {
    f32x4 a0 = cw.b[0], a1 = cw.b[1];
#pragma unroll
    for (int j = 0; j < 4; ++j) { const int r = row - 3 + j;
        if (r >= 0) { const u32x4 v = *(const u32x4*)(P + (size_t)r * LDP + PC_XBC + xch);
            a0[0] += cw.w[j][0][0] * bflo(v.x); a0[1] += cw.w[j][0][1] * bfhi(v.x); a0[2] += cw.w[j][0][2] * bflo(v.y); a0[3] += cw.w[j][0][3] * bfhi(v.y);
            a1[0] += cw.w[j][1][0] * bflo(v.z); a1[1] += cw.w[j][1][1] * bfhi(v.z); a1[2] += cw.w[j][1][2] * bflo(v.w); a1[3] += cw.w[j][1][3] * bfhi(v.w); } }
#pragma unroll
    for (int i = 0; i < 4; ++i) { o[i] = siluf_(a0[i]); o[4 + i] = siluf_(a1[i]); }
}
template <bool TR> __device__ __forceinline__ void conv_tile8(LAS unsigned char* dst, const bf16* P, int row0, int xch, int cgl, int lr,
                                                           const float* conv_w, const float* conv_b, const LAS float* sw) {
    ConvW cw; conv_load_w(cw, conv_w, conv_b, xch);
    u32x4 raw[11];
#pragma unroll
    for (int k = 0; k < 11; ++k) { const int r = row0 + lr * 8 - 3 + k; raw[k] = (r >= 0) ? *(const u32x4*)(P + (size_t)r * LDP + PC_XBC + xch) : (u32x4){0u, 0u, 0u, 0u}; }
    unsigned pk[8][2];
#pragma unroll
    for (int lp = 0; lp < 4; ++lp) { float o[2][8];
#pragma unroll
        for (int q = 0; q < 2; ++q) { f32x4 a0 = cw.b[0], a1 = cw.b[1];
#pragma unroll
            for (int j = 0; j < 4; ++j) { const u32x4 v = raw[2 * lp + q + j];
                a0[0] += cw.w[j][0][0] * bflo(v.x); a0[1] += cw.w[j][0][1] * bfhi(v.x); a0[2] += cw.w[j][0][2] * bflo(v.y); a0[3] += cw.w[j][0][3] * bfhi(v.y);
                a1[0] += cw.w[j][1][0] * bflo(v.z); a1[1] += cw.w[j][1][1] * bfhi(v.z); a1[2] += cw.w[j][1][2] * bflo(v.w); a1[3] += cw.w[j][1][3] * bfhi(v.w); }
            const float sc = sw ? sw[lr * 8 + 2 * lp + q] : 1.0f;
#pragma unroll
            for (int i = 0; i < 4; ++i) { o[q][i] = siluf_(a0[i]) * sc; o[q][4 + i] = siluf_(a1[i]) * sc; } }
        if (TR) {
#pragma unroll
            for (int e = 0; e < 8; ++e) pk[e][lp & 1] = cvtpk(o[0][e], o[1][e]);
            if (lp & 1) {
#pragma unroll
                for (int e = 0; e < 8; ++e) *(LAS u32x2*)(dst + (cgl * 8 + e) * 272 + lr * 16 + (lp >> 1) * 8) = (u32x2){pk[e][0], pk[e][1]}; }
        } else {
#pragma unroll
            for (int q = 0; q < 2; ++q) { u32x4 pw; pw.x = cvtpk(o[q][0], o[q][1]); pw.y = cvtpk(o[q][2], o[q][3]); pw.z = cvtpk(o[q][4], o[q][5]); pw.w = cvtpk(o[q][6], o[q][7]);
                *(LAS u32x4*)(dst + (lr * 8 + 2 * lp + q) * 272 + cgl * 16) = pw; } } }
}
__device__ __forceinline__ void chunk_decay(const float* dtbuf, int row0, int head, float bias, float Aneg, int lane, float& dt0, float& dt1, float& ac0, float& ac1) {
    float r0 = dtbuf[(size_t)(row0 + 2 * lane) * 32 + head] + bias, r1 = dtbuf[(size_t)(row0 + 2 * lane + 1) * 32 + head] + bias;
    dt0 = fmaxf(r0, 0.f) + log1pf(__expf(-fabsf(r0))); dt1 = fmaxf(r1, 0.f) + log1pf(__expf(-fabsf(r1)));
    const float a0 = dt0 * Aneg, a1 = dt1 * Aneg;
    float s = a0 + a1;
#pragma unroll
    for (int o = 1; o < 64; o <<= 1) { const float t = __shfl_up(s, o); if (lane >= o) s += t; }
    ac1 = s; ac0 = s - a1;
}

#define XB_TMO      128
#define XB_XCNT(j)  (256  + 64 * (j))
#define XB_XSUB(j)  (1280 + 64 * (j))
#define XB_XGEN(j)  (2304 + 64 * (j))
#define XB_TOP      3328
#define XB_TOPGEN   3392
#define XCD_BAR_WORDS 3456
#define XB_SPIN_CAP (1u << 18)

__device__ __forceinline__ unsigned xb_ld(unsigned* p)              { return __hip_atomic_load(p, __ATOMIC_RELAXED, __HIP_MEMORY_SCOPE_AGENT); }
__device__ __forceinline__ unsigned xb_add(unsigned* p, unsigned v) { return __hip_atomic_fetch_add(p, v, __ATOMIC_RELAXED, __HIP_MEMORY_SCOPE_AGENT); }
__device__ __forceinline__ unsigned xb_xcc_id() { return (unsigned)__builtin_amdgcn_s_getreg((3 << 11) | 20) & 0xFu; }
#define XB_SPIN(cond, bar) do { unsigned _sp = 0; while (cond) { __builtin_amdgcn_s_sleep(1); \
    if ((++_sp & 255u) == 0u) { if (xb_ld(&(bar)[XB_TMO])) break; if (_sp > XB_SPIN_CAP) { atomicAdd(&(bar)[XB_TMO], 1u); break; } } } } while (0)

struct XcdBarrier {
    unsigned* bar; unsigned x;
    volatile LAS unsigned* st;
};

__device__ __forceinline__ XcdBarrier xcd_barrier_post(unsigned* bar, volatile LAS unsigned* st) {
    XcdBarrier b; b.bar = bar; b.x = xb_xcc_id(); b.st = st;
    if (threadIdx.x == 0) (void)xb_add(&bar[XB_XCNT(b.x)], 1u);
    return b;
}
__device__ __forceinline__ void xcd_barrier_complete(unsigned* bar, unsigned x, unsigned& nloc, unsigned& nx) {
    const unsigned G = gridDim.x * gridDim.y * gridDim.z;
    unsigned sum, cnt, mine, sp = 0u;
    for (;;) {
        sum = 0u; cnt = 0u; mine = 0u;
#pragma unroll
        for (unsigned j = 0; j < 16; ++j) { const unsigned c = xb_ld(&bar[XB_XCNT(j)]); sum += c; cnt += (c > 0u) ? 1u : 0u; mine = (j == x) ? c : mine; }
        if (sum == G) break;
        __builtin_amdgcn_s_sleep(1);
        if ((++sp & 255u) == 0u) { if (xb_ld(&bar[XB_TMO])) break; if (sp > XB_SPIN_CAP) { atomicAdd(&bar[XB_TMO], 1u); break; } }
    }
    nloc = mine > 0u ? mine : 1u; nx = cnt > 0u ? cnt : 1u;
}

__device__ __forceinline__ void xcd_barrier(const XcdBarrier& b) {
    asm volatile("s_waitcnt vmcnt(0)" ::: "memory");
    __syncthreads();
    if (threadIdx.x == 0) {
        unsigned* bar = b.bar;
        __builtin_amdgcn_s_waitcnt(0);
        unsigned nloc = b.st[0], nx = b.st[1];
        if (nloc == 0u) { xcd_barrier_complete(bar, b.x, nloc, nx); b.st[0] = nloc; b.st[1] = nx; }
        const unsigned old = xb_add(&bar[XB_XSUB(b.x)], 1u);
        const unsigned gen = old / nloc;
        if (old + 1u == (gen + 1u) * nloc) {
            __builtin_amdgcn_fence(__ATOMIC_RELEASE, "agent");
            asm volatile("s_waitcnt vmcnt(0)" ::: "memory");
            const unsigned og = xb_add(&bar[XB_TOP], 1u);
            const unsigned tg = og / nx;
            if (og + 1u == (tg + 1u) * nx) xb_add(&bar[XB_TOPGEN], 1u);
            else XB_SPIN(xb_ld(&bar[XB_TOPGEN]) == tg, bar);
            __builtin_amdgcn_fence(__ATOMIC_ACQUIRE, "agent");
            xb_add(&bar[XB_XGEN(b.x)], 1u);
            asm volatile("s_waitcnt vmcnt(0)" ::: "memory");
        } else {
            XB_SPIN(xb_ld(&bar[XB_XGEN(b.x)]) == gen, bar);
            __builtin_amdgcn_fence(__ATOMIC_ACQUIRE, "agent");
            asm volatile("s_waitcnt vmcnt(0)" ::: "memory");
        }
    }
    __syncthreads();
}

constexpr int AT_QS = 0, AT_KS = 18432, AT_VT = 55296, AT_PS = 91136, AT_END = AT_PS + 8 * 16 * 336;
static_assert(AT_END <= 147456, "attention LDS");
__device__ __forceinline__ void attn_unit(LAS unsigned char* lds, bf16* P, int blk, int h, float sink, int tid_in, bool live = true) {
    int tid = tid_in; asm volatile("" : "+v"(tid));
    const int lane = tid & 63, w = __builtin_amdgcn_readfirstlane(tid >> 6), fr = lane & 15, kg = lane >> 4;
    const int row0 = blk * 128, g = h >> 2;
#pragma unroll
    for (int i = 0; i < 2; ++i) { const int idx = tid + 512 * i, r = idx >> 3, ch = idx & 7;
        const u32x4 v = *(const u32x4*)(P + (size_t)(row0 + r) * LDP + PC_Q + h * 64 + ch * 8); *(LAS u32x4*)(lds + AT_QS + r * 144 + ch * 16) = v; }
#pragma unroll
    for (int i = 0; i < 4; ++i) { const int idx = tid + 512 * i, kj = idx >> 3, ch = idx & 7; const int srow = (blk > 0) ? row0 - 128 + kj : row0 + (kj & 127);
        const u32x4 v = *(const u32x4*)(P + (size_t)srow * LDP + PC_K + g * 64 + ch * 8); *(LAS u32x4*)(lds + AT_KS + kj * 144 + ch * 16) = v; }
#pragma unroll
    for (int i = 0; i < 4; ++i) { const int idx = tid + 512 * i, kj = idx & 255, ch = idx >> 8; const int srow = (blk > 0) ? row0 - 128 + kj : row0 + (kj & 127);
        const u32x4 v = *(const u32x4*)(P + (size_t)srow * LDP + PC_V + g * 64 + ch * 8);
        LAS unsigned short* d = (LAS unsigned short*)(lds + AT_VT + (ch * 8) * 560 + kj * 2);
        d[0 * 280] = (unsigned short)(v.x & 0xffffu); d[1 * 280] = (unsigned short)(v.x >> 16); d[2 * 280] = (unsigned short)(v.y & 0xffffu); d[3 * 280] = (unsigned short)(v.y >> 16);
        d[4 * 280] = (unsigned short)(v.z & 0xffffu); d[5 * 280] = (unsigned short)(v.z >> 16); d[6 * 280] = (unsigned short)(v.w & 0xffffu); d[7 * 280] = (unsigned short)(v.w >> 16); }
    for (int idx = tid; idx < 64 * 12; idx += 512) { const int d = idx / 12, wv = idx % 12; *(LAS unsigned*)(lds + AT_VT + d * 560 + 512 + wv * 4) = 0u; }
    { const int row = lane >> 2, part = lane & 3; *(LAS u32x2*)(lds + AT_PS + w * 5376 + row * 336 + 288 + part * 8) = (u32x2){0u, 0u}; }
    __syncthreads();
    bf16x8 qf[2];
#pragma unroll
    for (int ks = 0; ks < 2; ++ks) qf[ks] = *(const LAS bf16x8*)(lds + AT_QS + (16 * w + fr) * 144 + (32 * ks + 8 * kg) * 2);
    f32x4 s[9];
#pragma unroll
    for (int ti = 0; ti < 9; ++ti) { const int t = w + ti; f32x4 acc = {0.f, 0.f, 0.f, 0.f};
#pragma unroll
        for (int ks = 0; ks < 2; ++ks) { const bf16x8 kf = *(const LAS bf16x8*)(lds + AT_KS + (16 * t + fr) * 144 + (32 * ks + 8 * kg) * 2); acc = MFMA16(kf, qf[ks], acc); }
        s[ti] = acc; }
    const int qi = 128 + 16 * w + fr; float mx = sink;
#pragma unroll
    for (int ti = 0; ti < 9; ++ti)
#pragma unroll
        for (int j = 0; j < 4; ++j) { const int kj = 16 * (w + ti) + 4 * kg + j, d = qi - kj; const bool valid = (d >= 0) && (d < 128) && (blk > 0 || kj >= 128);
            const float v = valid ? s[ti][j] * 0.125f : -INFINITY; s[ti][j] = v; mx = fmaxf(mx, v); }
    mx = fmaxf(mx, __shfl_xor(mx, 16)); mx = fmaxf(mx, __shfl_xor(mx, 32));
    float sum = 0.f;
#pragma unroll
    for (int ti = 0; ti < 9; ++ti) {
#pragma unroll
        for (int j = 0; j < 4; ++j) { const float p = __expf(s[ti][j] - mx); s[ti][j] = p; sum += p; }
        u32x2 pw; pw.x = cvtpk(s[ti][0], s[ti][1]); pw.y = cvtpk(s[ti][2], s[ti][3]);
        *(LAS u32x2*)(lds + AT_PS + w * 5376 + fr * 336 + (16 * ti + 4 * kg) * 2) = pw; }
    sum += __shfl_xor(sum, 16); sum += __shfl_xor(sum, 32);
    const float inv = 1.0f / (sum + __expf(sink - mx));
    LDS_WAIT(); asm volatile("" ::: "memory");
    f32x4 o[4];
#pragma unroll
    for (int dt = 0; dt < 4; ++dt) o[dt] = (f32x4){0.f, 0.f, 0.f, 0.f};
#pragma unroll
    for (int ks = 0; ks < 5; ++ks) { const bf16x8 pf = *(const LAS bf16x8*)(lds + AT_PS + w * 5376 + fr * 336 + (32 * ks + 8 * kg) * 2);
#pragma unroll
        for (int dt = 0; dt < 4; ++dt) { const bf16x8 vf = *(const LAS bf16x8*)(lds + AT_VT + (16 * dt + fr) * 560 + (16 * w + 32 * ks + 8 * kg) * 2); o[dt] = MFMA16(vf, pf, o[dt]); } }
    bf16* orow = P + (size_t)(row0 + 16 * w + fr) * LDP + PC_Q + h * 64 + 4 * kg;
#pragma unroll
    for (int dt = 0; dt < 4; ++dt) { u32x2 ow; ow.x = cvtpk(o[dt][0] * inv, o[dt][1] * inv); ow.y = cvtpk(o[dt][2] * inv, o[dt][3] * inv); if (live) *(u32x2*)(orow + 16 * dt) = ow; }
    __syncthreads();
}

constexpr int S1_BT = 0, S1_XW = 34816, S1_SW = 104448;
__device__ __forceinline__ void s1_unit(LAS unsigned char* lds, const bf16* P, const float* dtbuf, float* dec, bf16* states, int c, int g,
                                        const float* conv_w, const float* conv_b, const float* dt_bias, const float* a_log, int tid_in) {
    int tid = tid_in; asm volatile("" : "+v"(tid));
    const int lane = tid & 63, w = __builtin_amdgcn_readfirstlane(tid >> 6), fr = lane & 15, kg = lane >> 4;
    const int row0 = c * 128;
    { const int hh = 8 * g + w; const float Aneg = -__expf(a_log[hh]); float dt0, dt1, ac0, ac1;
      chunk_decay(dtbuf, row0, hh, dt_bias[hh], Aneg, lane, dt0, dt1, ac0, ac1);
      const float tot = __shfl(ac1, 63);
      LAS float* sw = (LAS float*)(lds + S1_SW) + w * 128;
      sw[2 * lane] = __expf(tot - ac0) * dt0; sw[2 * lane + 1] = __expf(tot - ac1) * dt1;
      if (lane == 63) dec[c * 32 + hh] = __expf(tot); }
    __syncthreads();
    if (tid < 256) { const int lr = tid & 15, cg = tid >> 4; conv_tile8<true>(lds + S1_BT, P, row0, 2048 + g * 128 + cg * 8, cg, lr, conv_w, conv_b, nullptr); }
#pragma unroll 1
    for (int half = 0; half < 2; ++half) {
        if (half) __syncthreads();
        { const int lr = tid & 15, cg = tid >> 4; conv_tile8<true>(lds + S1_XW, P, row0, g * 512 + half * 256 + cg * 8, cg, lr, conv_w, conv_b, (const LAS float*)(lds + S1_SW) + (half * 4 + (cg >> 3)) * 128); }
        __syncthreads();
        const int hl = w >> 1, ph = w & 1;
        f32x4 acc[2][8];
#pragma unroll
        for (int pt = 0; pt < 2; ++pt)
#pragma unroll
            for (int nt = 0; nt < 8; ++nt) acc[pt][nt] = (f32x4){0.f, 0.f, 0.f, 0.f};
#pragma unroll
        for (int ks = 0; ks < 4; ++ks) { bf16x8 xf[2];
#pragma unroll
            for (int pt = 0; pt < 2; ++pt) xf[pt] = *(const LAS bf16x8*)(lds + S1_XW + (hl * 64 + ph * 32 + 16 * pt + fr) * 272 + (32 * ks + 8 * kg) * 2);
#pragma unroll
            for (int nt = 0; nt < 8; ++nt) { const bf16x8 bfr = *(const LAS bf16x8*)(lds + S1_BT + (16 * nt + fr) * 272 + (32 * ks + 8 * kg) * 2);
#pragma unroll
                for (int pt = 0; pt < 2; ++pt) acc[pt][nt] = MFMA16(bfr, xf[pt], acc[pt][nt]); } }
        const int hh = 8 * g + half * 4 + hl;
#pragma unroll
        for (int pt = 0; pt < 2; ++pt) { bf16* sp = states + ((size_t)(c * 32 + hh) * 64 + ph * 32 + 16 * pt + fr) * 128 + 4 * kg;
#pragma unroll
            for (int nt = 0; nt < 8; ++nt) { u32x2 ow; ow.x = cvtpk(acc[pt][nt][0], acc[pt][nt][1]); ow.y = cvtpk(acc[pt][nt][2], acc[pt][nt][3]); *(u32x2*)(sp + 16 * nt) = ow; } }
    }
    __syncthreads();
}
__device__ __forceinline__ void scan_phase(bf16* states, const float* dec, int gtid, int nthr, bool live = true) {
    for (int e = gtid; e < 131072; e += nthr) { const int head = e >> 12; unsigned* p = (unsigned*)states + (size_t)head * 4096 + (e & 4095);
        float h0 = 0.f, h1 = 0.f;
#pragma unroll 32
        for (int c = 0; c < 64; ++c) { const float d = dec[c * 32 + head]; const unsigned v = p[(size_t)c * 131072]; if (live) p[(size_t)c * 131072] = cvtpk(h0, h1); h0 = d * h0 + bflo(v); h1 = d * h1 + bfhi(v); } }
}
constexpr int S3_CS = 0, S3_R = 34816, S3_AC = 104448, S3_DT = 108544;
__device__ __forceinline__ void s3_unit(LAS unsigned char* lds, bf16* P, const float* dtbuf, const bf16* states, int c, int g,
                                        const float* conv_w, const float* conv_b, const float* dt_bias, const float* a_log, const float* d_skip, const float* norm_w, int tid_in, bool live = true) {
    int tid = tid_in; asm volatile("" : "+v"(tid));
    const int lane = tid & 63, w = __builtin_amdgcn_readfirstlane(tid >> 6), fr = lane & 15, kg = lane >> 4;
    const int row0 = c * 128;
    { const int hh = 8 * g + w; const float Aneg = -__expf(a_log[hh]); float dt0, dt1, ac0, ac1;
      chunk_decay(dtbuf, row0, hh, dt_bias[hh], Aneg, lane, dt0, dt1, ac0, ac1);
      LAS float* ac = (LAS float*)(lds + S3_AC) + w * 128; LAS float* dv = (LAS float*)(lds + S3_DT) + w * 128;
      ac[2 * lane] = ac0; ac[2 * lane + 1] = ac1; dv[2 * lane] = dt0; dv[2 * lane + 1] = dt1; }
    { const int which = tid >> 8, t2 = tid & 255, cg = t2 & 15, lr = t2 >> 4;
      conv_tile8<false>(lds + (which ? S3_R : S3_CS), P, row0, (which ? 2048 : 2560) + g * 128 + cg * 8, cg, lr, conv_w, conv_b, nullptr); }
    __syncthreads();
    f32x4 cb[8];
    { bf16x8 cf[4];
#pragma unroll
    for (int ks = 0; ks < 4; ++ks) cf[ks] = *(const LAS bf16x8*)(lds + S3_CS + (16 * w + fr) * 272 + (32 * ks + 8 * kg) * 2);
#pragma unroll
    for (int ts = 0; ts < 8; ++ts) { f32x4 acc = {0.f, 0.f, 0.f, 0.f};
        if (ts <= w) {
#pragma unroll
            for (int ks = 0; ks < 4; ++ks) { const bf16x8 bfr = *(const LAS bf16x8*)(lds + S3_R + (16 * ts + fr) * 272 + (32 * ks + 8 * kg) * 2); acc = MFMA16(bfr, cf[ks], acc); } }
        cb[ts] = acc; } }
    asm volatile("" ::: "memory");
    float ssq = 0.f;
    const int lme = 16 * w + fr;
#pragma unroll 1
    for (int hidx = 0; hidx < 8; ++hidx) {
        if ((hidx & 3) == 0) {
            __syncthreads();
            { const int half = hidx >> 2, lr = tid & 15, cg = tid >> 4; conv_tile8<true>(lds + S3_R, P, row0, g * 512 + half * 256 + cg * 8, cg, lr, conv_w, conv_b, nullptr); }
            __syncthreads();
        }
        const int hl = hidx & 3, hh = 8 * g + hidx;
        const LAS float* ac = (const LAS float*)(lds + S3_AC) + hidx * 128; const LAS float* dv = (const LAS float*)(lds + S3_DT) + hidx * 128;
        const float acl = ac[lme];
        f32x4 accD[4], accO[4];
#pragma unroll
        for (int pt = 0; pt < 4; ++pt) { accD[pt] = (f32x4){0.f, 0.f, 0.f, 0.f}; accO[pt] = (f32x4){0.f, 0.f, 0.f, 0.f}; }
#pragma unroll
        for (int ks = 0; ks < 4; ++ks) {
            if (2 * ks <= w) { float mv[8];
#pragma unroll
                for (int tsub = 0; tsub < 2; ++tsub) { const int ts = 2 * ks + tsub; const f32x4 as = *(const LAS f32x4*)(ac + 16 * ts + 4 * kg), ds = *(const LAS f32x4*)(dv + 16 * ts + 4 * kg);
#pragma unroll
                    for (int j = 0; j < 4; ++j) { const int sidx = 16 * ts + 4 * kg + j; mv[4 * tsub + j] = (sidx <= lme) ? cb[ts][j] * __expf(acl - as[j]) * ds[j] : 0.f; } }
                u32x4 mw; mw.x = cvtpk(mv[0], mv[1]); mw.y = cvtpk(mv[2], mv[3]); mw.z = cvtpk(mv[4], mv[5]); mw.w = cvtpk(mv[6], mv[7]);
                const bf16x8 mf = __builtin_bit_cast(bf16x8, mw);
#pragma unroll
                for (int pt = 0; pt < 4; ++pt) { const int chan = hl * 64 + 16 * pt + fr;
                    const u32x2 lo = *(const LAS u32x2*)(lds + S3_R + chan * 272 + (32 * ks + 4 * kg) * 2), hi = *(const LAS u32x2*)(lds + S3_R + chan * 272 + (32 * ks + 16 + 4 * kg) * 2);
                    const u32x4 xw = {lo.x, lo.y, hi.x, hi.y}; accD[pt] = MFMA16(__builtin_bit_cast(bf16x8, xw), mf, accD[pt]); } } }
        { bf16x8 cf2[4];
#pragma unroll
          for (int ks = 0; ks < 4; ++ks) cf2[ks] = *(const LAS bf16x8*)(lds + S3_CS + (16 * w + fr) * 272 + (32 * ks + 8 * kg) * 2);
#pragma unroll
        for (int pt = 0; pt < 4; ++pt) { const bf16* pp = states + ((size_t)(c * 32 + hh) * 64 + 16 * pt + fr) * 128 + 8 * kg;
#pragma unroll
            for (int ks = 0; ks < 4; ++ks) { const bf16x8 pf = *(const bf16x8*)(pp + 32 * ks); accO[pt] = MFMA16(pf, cf2[ks], accO[pt]); }
            asm volatile("" ::: "memory"); } }
        const float ea = __expf(acl), Dh = d_skip[hh];
#pragma unroll
        for (int pt = 0; pt < 4; ++pt) { const int p0 = 16 * pt + 4 * kg;
            bf16* zp = P + (size_t)(row0 + lme) * LDP + PC_Z + hh * 64 + p0; const u32x2 zv = *(const u32x2*)zp;
            const float zs[4] = {bflo(zv.x), bfhi(zv.x), bflo(zv.y), bfhi(zv.y)}; float uu[4];
#pragma unroll
            for (int j = 0; j < 4; ++j) { const float xs = __uint_as_float((unsigned)(*(const LAS unsigned short*)(lds + S3_R + (hl * 64 + p0 + j) * 272 + lme * 2)) << 16);
                uu[j] = (accD[pt][j] + ea * accO[pt][j] + Dh * xs) * siluf_(zs[j]); }
            u32x2 uw; uw.x = cvtpk(uu[0], uu[1]); uw.y = cvtpk(uu[2], uu[3]);
            ssq += bflo(uw.x) * bflo(uw.x) + bfhi(uw.x) * bfhi(uw.x) + bflo(uw.y) * bflo(uw.y) + bfhi(uw.y) * bfhi(uw.y);
            if (live) *(u32x2*)zp = uw; }
    }
    ssq += __shfl_xor(ssq, 16); ssq += __shfl_xor(ssq, 32);
    const float rs = 1.0f / sqrtf(ssq * (1.0f / 512.0f) + RMS_EPS);
#pragma unroll 1
    for (int hidx = 0; hidx < 8; ++hidx)
#pragma unroll
        for (int pt = 0; pt < 4; ++pt) { const int col = (8 * g + hidx) * 64 + 16 * pt + 4 * kg; const f32x4 nw = *(const f32x4*)(norm_w + col);
            bf16* up = P + (size_t)(row0 + lme) * LDP + PC_Z + col; const u32x2 uv = *(const u32x2*)up;
            u32x2 ow; ow.x = cvtpk(bflo(uv.x) * rs * nw[0], bfhi(uv.x) * rs * nw[1]); ow.y = cvtpk(bflo(uv.y) * rs * nw[2], bfhi(uv.y) * rs * nw[3]); if (live) *(u32x2*)up = ow; }
    __syncthreads();
}
typedef __attribute__((address_space(4))) const char* kptr_t;
typedef void* vp_t; typedef __attribute__((address_space(4))) const vp_t* kpp_t;
#define KARG_PTR(off) ({ kptr_t kp_ = (kptr_t)__builtin_amdgcn_kernarg_segment_ptr(); asm volatile("" : "+s"(kp_)); *(kpp_t)(kp_ + (off)); })
#define IN(i) ((const float*)KARG_PTR(8 * (i)))
#define OUTP ((float*)KARG_PTR(192))
#define WSP ((unsigned char*)KARG_PTR(200))
#define Wgu ((bf16*)(WSP + WS_WGU))
#define Wd ((bf16*)(WSP + WS_WD))
#define Win ((bf16*)(WSP + WS_WIN))
#define Wcat ((bf16*)(WSP + WS_WCAT))
#define Wout ((bf16*)(WSP + WS_WOUT))
#define x1f ((float*)(WSP + WS_X1F))
#define big ((bf16*)(WSP + WS_BIG))
#define dtbuf ((float*)(WSP + WS_DT))
#define dec ((float*)(WSP + WS_DEC))
#define xb ((bf16*)((unsigned char*)OUTP + DO_XB))
#define states ((bf16*)((unsigned char*)OUTP + DO_ST))
struct Args { const float* in[24]; float* out; unsigned char* ws; };
__global__ void __launch_bounds__(NTHR, 2) mega_fwd(Args a) {
    extern __shared__ __attribute__((aligned(16))) unsigned char lds_raw[];
    LAS unsigned char* lds = (LAS unsigned char*)lds_raw;
    cg::grid_group grid = cg::this_grid();
    const int G = gridDim.x, bid = blockIdx.x, NGW = G * NWAVES, nthr = G * NTHR;
#define TID_FRESH() ({ int t_ = threadIdx.x; asm volatile("" : "+v"(t_)); t_; })
#define PHASE_IDS const int tid = TID_FRESH(); const int lane = tid & 63, wave = __builtin_amdgcn_readfirstlane(tid >> 6), gw = bid * NWAVES + wave, gtid = bid * NTHR + tid; (void)lane; (void)gw; (void)gtid; LAS float* scr = (LAS float*)(lds + wave * 16384); (void)scr;
    volatile LAS unsigned* MISC = (volatile LAS unsigned*)(lds + LDS_BYTES - 64);
    if (threadIdx.x < 16) MISC[threadIdx.x] = 0u;
    __syncthreads();
    (void)xcd_barrier_post((unsigned*)(WSP + WS_CTL), MISC + 8);
#define GRID_BAR() do { XcdBarrier b_; b_.bar = (unsigned*)(WSP + WS_CTL); b_.x = xb_xcc_id(); b_.st = (volatile LAS unsigned*)(lds + LDS_BYTES - 64) + 8; xcd_barrier(b_); } while (0)

    { PHASE_IDS
    ffn_weight_items(IN(1), IN(2), IN(3), Wgu, Wd, scr, gw, NGW, lane, 0, 2 * 16 * 88);
    { const float* xin = IN(0); bf16* xbo = xb;
    for (int i = gtid; i < M * 1024 / 8; i += nthr) { const f32x4 v0 = *((const f32x4*)xin + 2 * (size_t)i), v1 = *((const f32x4*)xin + 2 * (size_t)i + 1);
        u32x4 o; o.x = cvtpk(v0.x, v0.y); o.y = cvtpk(v0.z, v0.w); o.z = cvtpk(v1.x, v1.y); o.w = cvtpk(v1.z, v1.w); *((u32x4*)xbo + i) = o; } } }
    if (IN(9)[0] > 1e30f) grid.sync();
    GRID_BAR();
#ifndef SKIP_GEMM1
    { pg8::Gemm g{xb, Wgu, M, 2 * DFF, 1024, 1024}; pg8::StaticOrder S; S.init(M, 2 * DFF, G, bid); pg8::EpiSwiGLU E{0, big, DFF};
      pg8::gemm_phase<pg8::EpiSwiGLU, pg8::StaticOrder, true, true>(lds, g, S, E); }
#endif
    if (bid >= 128) { PHASE_IDS const int gw2 = (bid - 128) * NWAVES + wave, NGW2 = (G - 128) * NWAVES;
        ffn_weight_items(IN(1), IN(2), IN(3), Wgu, Wd, scr, gw2, NGW2, lane, 2 * 16 * 88, 2 * 16 * 88 + 44 * 32);
    for (int it = gw2; it < 16 * 273; it += NGW2) { const int kb = it / 273, nb = it % 273, n0 = nb * 32; tr_item(IN(6), 8736, kb * 64, n0, Win, 1024, map_in(n0), kb * 64, scr, lane); }
    for (int i = (bid - 128) * NTHR + tid; i < 224 * 1024 / 8; i += (G - 128) * NTHR) *((u32x4*)(Win + (size_t)8736 * 1024) + i) = (u32x4){0u, 0u, 0u, 0u};
    }
    GRID_BAR();
#ifndef SKIP_GEMM2
    { pg8::Gemm g{big, Wd, M, 1024, DFF, DFF}; pg8::StaticOrder S; S.init(M, 1024, G, bid); pg8::EpiResid E{0, IN(0), x1f, 1024, ALPHA, 0.5f};
      pg8::gemm_phase<pg8::EpiResid, pg8::StaticOrder, true, true>(lds, g, S, E); }
#endif
    GRID_BAR();
    { PHASE_IDS ln_rows(x1f, x1f, xb, IN(4), IN(5), M, gw, NGW, lane); }
    GRID_BAR();
#pragma unroll 1
    for (int b = 0; b < 2; ++b) {
#ifndef SKIP_GEMM3
        { pg8::Gemm g{xb + (size_t)b * MB * 1024, Win, MB, NPROJ, 1024, 1024}; pg8::StaticOrder S; S.init(MB, NPROJ, G, bid); pg8::EpiInProj E{0, big, LDP, dtbuf};
          pg8::gemm_phase<pg8::EpiInProj, pg8::StaticOrder, true, true>(lds, g, S, E); }
#endif
        if (bid >= 96) { PHASE_IDS const int gw2 = (bid - 96) * NWAVES + wave, NGW2 = (G - 96) * NWAVES;
            if (b == 0) {
    for (int it = gw2; it < 512 + 1024 + 512; it += NGW2) { int r = it;
                if (r < 512) { tr_item(IN(14), 1024, (r >> 5) * 64, (r & 31) * 32, Wcat, 1024, (r & 31) * 32, (r >> 5) * 64, scr, lane); continue; } r -= 512;
                if (r < 1024) { tr_item(IN(15), 1024, (r >> 5) * 64, (r & 31) * 32, Wcat + (size_t)1024 * 1024, 2048, (r & 31) * 32, (r >> 5) * 64, scr, lane); continue; } r -= 1024;
                tr_item(IN(16), 1024, (r >> 5) * 64, (r & 31) * 32, Wout, 1024, (r & 31) * 32, (r >> 5) * 64, scr, lane); }
            } else ffn_weight_items(IN(19), IN(20), IN(21), Wgu, Wd, scr, gw2, NGW2, lane); }
        GRID_BAR();
#ifndef SKIP_S1
        for (int u = bid; u < 256; u += G) s1_unit(lds, big, dtbuf, dec, states, u >> 2, u & 3, IN(7), IN(8), IN(9), IN(10), threadIdx.x);
#endif
#ifndef SKIP_ATTN
#if PROBE_DUP == 1
        { const bool never = IN(9)[0] > 1e30f; for (int u = bid; u < 1024; u += G) attn_unit(lds, big, u >> 4, u & 15, IN(13)[u & 15], threadIdx.x, never); }
#endif
        for (int u = bid; u < 1024; u += G) attn_unit(lds, big, u >> 4, u & 15, IN(13)[u & 15], threadIdx.x);
#endif
        GRID_BAR();
#if PROBE_DUP == 2
        { PHASE_IDS const bool never = IN(9)[0] > 1e30f; scan_phase(states, dec, gtid, nthr, never); }
#endif
        { PHASE_IDS scan_phase(states, dec, gtid, nthr); }
        GRID_BAR();
#ifndef SKIP_S3
#if PROBE_DUP == 3
        { const bool never = IN(9)[0] > 1e30f; for (int u = bid; u < 256; u += G) s3_unit(lds, big, dtbuf, states, u >> 2, u & 3, IN(7), IN(8), IN(9), IN(10), IN(11), IN(12), threadIdx.x, never); }
#endif
        for (int u = bid; u < 256; u += G) s3_unit(lds, big, dtbuf, states, u >> 2, u & 3, IN(7), IN(8), IN(9), IN(10), IN(11), IN(12), threadIdx.x);
#endif
        GRID_BAR();
#ifndef SKIP_G4
        { pg8::Gemm g{big + PC_Q, Wcat, MB, 1024, 1024, LDP}; pg8::StaticOrder S; S.init(MB, 1024, G, bid); pg8::EpiGate<0> E{0, big + PC_GA, LDP, PC_GS - PC_GA, nullptr, 0};
          pg8::gemm_phase<pg8::EpiGate<0>, pg8::StaticOrder, true, true>(lds, g, S, E); }
        { pg8::Gemm g{big + PC_Z, Wcat + (size_t)1024 * 1024, MB, 1024, 2048, LDP}; pg8::StaticOrder S; S.init(MB, 1024, G, bid); pg8::EpiGate<1> E{0, big + PC_GA, LDP, PC_GS - PC_GA, xb + (size_t)b * MB * 1024, 1024};
          pg8::gemm_phase<pg8::EpiGate<1>, pg8::StaticOrder, true, true>(lds, g, S, E); }
#endif
        GRID_BAR();
    }
    { pg8::Gemm g{xb, Wout, M, 1024, 1024, 1024}; pg8::StaticOrder S; S.init(M, 1024, G, bid); pg8::EpiResid E{0, x1f, x1f, 1024, ALPHA, 1.0f};
      pg8::gemm_phase<pg8::EpiResid, pg8::StaticOrder, true, true>(lds, g, S, E); }
    GRID_BAR();
    { PHASE_IDS ln_rows(x1f, x1f, xb, IN(17), IN(18), M, gw, NGW, lane); }
    GRID_BAR();
#ifndef SKIP_GEMM5
    { pg8::Gemm g{xb, Wgu, M, 2 * DFF, 1024, 1024}; pg8::StaticOrder S; S.init(M, 2 * DFF, G, bid); pg8::EpiSwiGLU E{0, big, DFF};
      pg8::gemm_phase<pg8::EpiSwiGLU, pg8::StaticOrder, true, true>(lds, g, S, E); }
#endif
    GRID_BAR();
#ifndef SKIP_GEMM6
    { pg8::Gemm g{big, Wd, M, 1024, DFF, DFF}; pg8::StaticOrder S; S.init(M, 1024, G, bid); pg8::EpiResid E{0, x1f, OUTP, 1024, ALPHA, 0.5f};
      pg8::gemm_phase<pg8::EpiResid, pg8::StaticOrder, true, true>(lds, g, S, E); }
#endif
    GRID_BAR();
    { PHASE_IDS ln_rows(OUTP, OUTP, nullptr, IN(22), IN(23), M, gw, NGW, lane); }
}

#undef Wgu
#undef Wd
#undef Win
#undef Wcat
#undef Wout
#undef x1f
#undef big
#undef dtbuf
#undef dec
#undef xb
#undef states
extern "C" void kernel_launch(void* const* d_in, const int* in_sizes, int n_in, void* d_out, int out_size, void* d_ws, size_t ws_size, hipStream_t stream) {
    static int grid = 0;
    if (grid == 0) {
        if (n_in != 24 || out_size != M * 1024 || ws_size < WS_END) { fprintf(stderr, "kernel_launch: unexpected shapes (n_in %d out %d ws %zu)\n", n_in, out_size, ws_size); grid = -1; return; }
        int dev = 0, cus = 0, per_cu = 0;
        (void)hipGetDevice(&dev); (void)hipDeviceGetAttribute(&cus, hipDeviceAttributeMultiprocessorCount, dev);
        (void)hipFuncSetAttribute((const void*)mega_fwd, hipFuncAttributeMaxDynamicSharedMemorySize, LDS_BYTES);
        (void)hipOccupancyMaxActiveBlocksPerMultiprocessor(&per_cu, (const void*)mega_fwd, NTHR, LDS_BYTES);
        if (per_cu < 1) per_cu = 1;
        grid = cus * per_cu; if (grid > 256) grid = 256;
        (void)hipGetLastError();
    }
    if (grid < 0) return;
    if (hipMemsetAsync((char*)d_ws + WS_CTL, 0, 65536, stream) != hipSuccess) { fprintf(stderr, "memset failed\n"); return; }
    Args a{};
    for (int i = 0; i < 24; ++i) a.in[i] = (const float*)d_in[i];
    a.out = (float*)d_out; a.ws = (unsigned char*)d_ws;
    void* args[] = {&a};
    hipError_t e = hipLaunchCooperativeKernel((const void*)mega_fwd, dim3(grid), dim3(NTHR), args, LDS_BYTES, stream);
    if (e != hipSuccess) fprintf(stderr, "cooperative launch failed: %s (grid %d)\n", hipGetErrorString(e), grid);
}
```
